# Optimizing an MI355X kernel written in HIP

```python
import math
import jax, jax.numpy as jnp
from jax import lax
import numpy as np

D_MODEL = 1024
BATCH = 16
SEQ = 4096
DEPTH = 2

D_CONV = D_MODEL
D_HYENA = D_MODEL
N_BRANCHES = 2
CONV_WIDTH = 3
HYENA_ORDER = 2
N_DIRECTIONS = 2
POS_BANDS = 16
POS_EMB_DIM = 1 + 2 * POS_BANDS
FILTER_HIDDEN = 64
DECAY_TARGET = 1e-2
FAST_DECAY_PCT = 0.3
SLOW_DECAY_PCT = 1.5
PROJ_COLS = 3 * D_CONV + (HYENA_ORDER + 1) * D_HYENA + N_BRANCHES * D_MODEL
D_FF = 2816
N_EXPERTS = 8
TOP_K = 2
D_FF_EXPERT = 3584
N_DENSE = (DEPTH + 1) // 2
N_MOE = DEPTH // 2
DEEPNORM_ALPHA = (2 * DEPTH) ** 0.25
DEEPNORM_BETA = (8 * DEPTH) ** -0.25
LN_EPS = 1e-5

kernel_name = "hybrid_shortconv_hyena_moe_deepnorm_encoder"


def layer_norm(x, g, b):
    xf = x.astype(jnp.float32)
    mu = jnp.mean(xf, axis=-1, keepdims=True)
    var = jnp.mean(jnp.square(xf - mu), axis=-1, keepdims=True)
    return ((xf - mu) * lax.rsqrt(var + LN_EPS)).astype(x.dtype) * g + b


def dwconv3_centred(u, w):
    up = jnp.pad(u, ((0, 0), (1, 1), (0, 0)))
    return up[:, :-2] * w[0] + up[:, 1:-1] * w[1] + up[:, 2:] * w[2]


def hyena_pos_features(L):
    t = jnp.linspace(0.0, 1.0, L, dtype=jnp.float32)[:, None]
    bands = jnp.linspace(1e-4, POS_BANDS - 1, POS_BANDS, dtype=jnp.float32)[None, :]
    w = (2.0 * math.pi / L) * jnp.arange(L, dtype=jnp.float32)[:, None]
    ang = bands * w
    return jnp.concatenate([t, jnp.cos(ang), -jnp.sin(ang)], axis=-1), t


def decay_window(t):
    max_decay = math.log(DECAY_TARGET) / FAST_DECAY_PCT
    min_decay = math.log(DECAY_TARGET) / SLOW_DECAY_PCT
    deltas = jnp.linspace(min_decay, max_decay, D_HYENA, dtype=jnp.float32)
    return jnp.exp(-t * jnp.abs(deltas)[None, :])


def implicit_filters(L, w1, b1, freq, w2, b2, w3):
    f32 = jnp.float32
    z, t = hyena_pos_features(L)
    fr = freq.astype(f32)
    h = jnp.sin(fr * (z @ w1.astype(f32) + b1.astype(f32)))
    h = jnp.sin(fr * (h @ w2.astype(f32) + b2.astype(f32)))
    h = (h @ w3.astype(f32)).reshape(L, N_DIRECTIONS, D_HYENA)
    h = h * decay_window(t)[:, None, :]
    h = h * lax.rsqrt(jnp.sum(jnp.square(h), axis=0, keepdims=True) + 1e-6)
    return h[:, 0], h[:, 1]


def bidirectional_fft_conv(u, k_fwd, k_bwd):
    L = u.shape[1]
    n = 2 * L
    kern = jnp.concatenate([k_fwd, jnp.zeros_like(k_fwd[:1]), k_bwd[:0:-1]], axis=0)
    kf = jnp.fft.rfft(kern, n=n, axis=0)
    uf = jnp.fft.rfft(u.astype(jnp.float32), n=n, axis=1)
    y = jnp.fft.irfft(uf * kf[None], n=n, axis=1)[:, :L]
    return y.astype(u.dtype)


def hybrid_mixer(x, w_in, conv_a_w, conv_h_w, conv_h_b, flt_w1, flt_b1, flt_freq, flt_w2, flt_b2, flt_w3,
                 hyena_bias, w_a_out, w_h_out, w_o):
    proj = jnp.einsum('bsd,dp->bsp', x, w_in)
    a_b, a_c, a_u, h_in, gate_logits = jnp.split(
        proj, [D_CONV, 2 * D_CONV, 3 * D_CONV, 3 * D_CONV + (HYENA_ORDER + 1) * D_HYENA], axis=-1)
    y_a = a_b * dwconv3_centred(a_c * a_u, conv_a_w)
    h_in = dwconv3_centred(h_in, conv_h_w) + conv_h_b
    h_v, h_x1, h_x0 = jnp.split(h_in, HYENA_ORDER + 1, axis=-1)
    k_fwd, k_bwd = implicit_filters(x.shape[1], flt_w1, flt_b1, flt_freq, flt_w2, flt_b2, flt_w3)
    z = h_v * h_x1
    z = bidirectional_fft_conv(z, k_fwd, k_bwd) + z * hyena_bias
    y_h = h_x0 * z
    g_a, g_h = jnp.split(jax.nn.sigmoid(gate_logits), N_BRANCHES, axis=-1)
    merged = (g_a * jnp.einsum('bsc,cd->bsd', y_a, w_a_out)
              + g_h * jnp.einsum('bsc,cd->bsd', y_h, w_h_out))
    return jnp.einsum('bsd,de->bse', merged, w_o)


def swiglu(x, w1, w3, w2):
    return (jax.nn.silu(x @ w1) * (x @ w3)) @ w2


def moe_swiglu(x, router, w1, w3, w2):
    bsz, seq, d = x.shape
    xt = x.reshape(bsz * seq, d)
    logits = (xt @ router).astype(jnp.float32)
    top_vals, top_idx = lax.top_k(logits, TOP_K)
    top_w = jax.nn.softmax(top_vals, axis=-1)
    combine = jnp.einsum('tk,tke->te', top_w,
                         jax.nn.one_hot(top_idx, N_EXPERTS, dtype=jnp.float32)).astype(x.dtype)
    y = jnp.zeros_like(xt)
    for e in range(N_EXPERTS):
        y = y + combine[:, e:e + 1] * swiglu(xt, w1[e], w3[e], w2[e])
    return y.reshape(bsz, seq, d)


def setup_inputs(seed: int = 0) -> dict:
    key = jax.random.key(seed)
    ks = iter(jax.random.split(key, 32))

    def nrm(shape, scale):
        return jax.random.normal(next(ks), shape, jnp.float32) * scale

    D = D_MODEL
    return {
        "x": nrm((BATCH, SEQ, D), 1.0),
        "ln_in_g": 1.0 + nrm((D,), 0.01),
        "ln_in_b": nrm((D,), 0.01),
        "w_in": nrm((DEPTH, D, PROJ_COLS), D ** -0.5),
        "conv_a_w": nrm((DEPTH, CONV_WIDTH, D_CONV), CONV_WIDTH ** -0.5),
        "conv_h_w": nrm((DEPTH, CONV_WIDTH, (HYENA_ORDER + 1) * D_HYENA), CONV_WIDTH ** -0.5),
        "conv_h_b": nrm((DEPTH, (HYENA_ORDER + 1) * D_HYENA), 0.01),
        "flt_w1": nrm((DEPTH, POS_EMB_DIM, FILTER_HIDDEN), POS_EMB_DIM ** -0.5),
        "flt_b1": nrm((DEPTH, FILTER_HIDDEN), 0.01),
        "flt_freq": 1.0 + nrm((DEPTH, FILTER_HIDDEN), 0.01),
        "flt_w2": nrm((DEPTH, FILTER_HIDDEN, FILTER_HIDDEN), FILTER_HIDDEN ** -0.5),
        "flt_b2": nrm((DEPTH, FILTER_HIDDEN), 0.01),
        "flt_w3": nrm((DEPTH, FILTER_HIDDEN, N_DIRECTIONS * D_HYENA), FILTER_HIDDEN ** -0.5),
        "hyena_bias": nrm((DEPTH, D_HYENA), 1.0),
        "w_a_out": nrm((DEPTH, D_CONV, D), D_CONV ** -0.5),
        "w_h_out": nrm((DEPTH, D_HYENA, D), D_HYENA ** -0.5),
        "w_o": nrm((DEPTH, D, D), DEEPNORM_BETA * D ** -0.5),
        "ln_mix_g": 1.0 + nrm((DEPTH, D), 0.01),
        "ln_mix_b": nrm((DEPTH, D), 0.01),
        "ffn_w1": nrm((N_DENSE, D, D_FF), D ** -0.5),
        "ffn_w3": nrm((N_DENSE, D, D_FF), D ** -0.5),
        "ffn_w2": nrm((N_DENSE, D_FF, D), DEEPNORM_BETA * D_FF ** -0.5),
        "moe_router": nrm((N_MOE, D, N_EXPERTS), D ** -0.5),
        "moe_w1": nrm((N_MOE, N_EXPERTS, D, D_FF_EXPERT), D ** -0.5),
        "moe_w3": nrm((N_MOE, N_EXPERTS, D, D_FF_EXPERT), D ** -0.5),
        "moe_w2": nrm((N_MOE, N_EXPERTS, D_FF_EXPERT, D), DEEPNORM_BETA * D_FF_EXPERT ** -0.5),
        "ln_ffn_g": 1.0 + nrm((DEPTH, D), 0.01),
        "ln_ffn_b": nrm((DEPTH, D), 0.01),
    }


def reference(x, ln_in_g, ln_in_b, w_in, conv_a_w, conv_h_w, conv_h_b, flt_w1, flt_b1, flt_freq, flt_w2, flt_b2,
              flt_w3, hyena_bias, w_a_out, w_h_out, w_o, ln_mix_g, ln_mix_b, ffn_w1, ffn_w3, ffn_w2, moe_router,
              moe_w1, moe_w3, moe_w2, ln_ffn_g, ln_ffn_b):
    h = layer_norm(x, ln_in_g, ln_in_b)
    for l in range(DEPTH):
        mix = hybrid_mixer(h, w_in[l], conv_a_w[l], conv_h_w[l], conv_h_b[l], flt_w1[l], flt_b1[l], flt_freq[l],
                           flt_w2[l], flt_b2[l], flt_w3[l], hyena_bias[l], w_a_out[l], w_h_out[l], w_o[l])
        h = layer_norm(DEEPNORM_ALPHA * h + mix, ln_mix_g[l], ln_mix_b[l])
        j = l // 2
        if l % 2 == 0:
            f = swiglu(h, ffn_w1[j], ffn_w3[j], ffn_w2[j])
        else:
            f = moe_swiglu(h, moe_router[j], moe_w1[j], moe_w3[j], moe_w2[j])
        h = layer_norm(DEEPNORM_ALPHA * h + f, ln_ffn_g[l], ln_ffn_b[l])
    return h
```

```cpp
#include <hip/hip_runtime.h>
#include <cstdio>
#include <cstdint>

#ifndef MK_PER_PHASE
#define MK_PER_PHASE 0
#endif

namespace pg8 {
#define PG8_LAS __attribute__((address_space(3)))
typedef unsigned short bf16_t;
typedef short bf16x8 __attribute__((ext_vector_type(8)));
typedef short s16x4 __attribute__((ext_vector_type(4)));
typedef float f32x4 __attribute__((ext_vector_type(4)));
typedef unsigned u32x4 __attribute__((ext_vector_type(4)));
typedef int i32x4 __attribute__((ext_vector_type(4)));
typedef int i32x8 __attribute__((ext_vector_type(8)));
constexpr int BM = 256, BK = 64, HALF = 128, HTB = HALF * BK * 2  , STAGE_BYTES = 8 * HTB, NXCD = 8, WGM = 8;

__host__ __device__ __forceinline__ int lds_byte(int r, int c) { const int st = (r >> 4) * 2 + (c >> 5), rr = r & 15, cc = c & 31, ob = rr * 64 + cc * 2; return st * 1024 + (ob ^ (((ob >> 9) & 1) << 5)); }
__host__ __device__ __forceinline__ void stage_rc(int b, int& R, int& C) { const int st = b / 1024, sb = b % 1024, swz = sb ^ (((sb >> 9) & 1) << 5); R = (st >> 1) * 16 + swz / 64; C = (st & 1) * 32 + (swz % 64) / 2; }
__host__ __device__ __forceinline__ int perm32(int rho) { const int n = rho >> 4, i = rho & 15; return 8 * (i >> 2) + 4 * n + (i & 3); }

struct Unit { int pm, pn; };
struct Gemm { const bf16_t* A; const bf16_t* Bt; int M, N, K; int sa = 0, sb = 0; const bf16_t* A2 = nullptr; const bf16_t* B2t = nullptr; };

struct StaticOrder {
    int nM, nN, nwg, G, c, rev;
    __host__ __device__ void init(int M, int N, int G_, int c_, int rev_ = 0) { nM = M / BM; nN = N / BM; nwg = nM * nN; G = G_; c = c_; rev = (rev_ && nwg % G_ == 0) ? 1 : 0; }
    __host__ __device__ bool next(int i, Unit& u) const {
        const long L = (long)(rev ? (nwg / G - 1 - i) : i) * G + c; if (i < 0 || L < 0 || L >= nwg) return false;
        int wgid = (int)L; { const int q = nwg / NXCD, r = nwg % NXCD, xcd = wgid % NXCD, off = wgid / NXCD; wgid = (xcd < r ? xcd * (q + 1) : r * (q + 1) + (xcd - r) * q) + off; }
        const int nig = WGM * nN, gid = wgid / nig, fm = gid * WGM, gsz = (nM - fm) < WGM ? (nM - fm) : WGM;
        u.pm = fm + ((wgid % nig) % gsz); u.pn = (wgid % nig) / gsz; return true;
    }
    __device__ __forceinline__ void a_ready(const Unit&) const {}
    __device__ __forceinline__ void done(const Unit&) const {}
};

struct MoeOrder : StaticOrder {
    int ts[9], NT, nh, skip;
    __device__ void initm(const int* tab, int NT_, int G_, int c_, int nh_, int skip_, int rev_ = 0) {
#pragma unroll
        for (int e = 0; e < 9; ++e) ts[e] = __builtin_amdgcn_readfirstlane((int)__hip_atomic_load((unsigned*)tab + e, __ATOMIC_RELAXED, __HIP_MEMORY_SCOPE_AGENT));
        NT = NT_; nM = ts[8]; nN = NT_; nwg = nM * nN; G = G_; c = c_; nh = nh_; skip = skip_; rev = (rev_ && nh_ == 0 && skip_ == 0) ? 1 : 0; }
    __device__ bool next(int i, Unit& u) const {
        long L;
        if (rev) { const int nrc = (nwg - c + G - 1) / G; if (i >= nrc) return false; L = (long)(nrc - 1 - i) * G + c; }
        else if (c < nh) L = (long)skip * (G - nh) + (long)i * G + c;
        else if (i < skip) L = (long)i * (G - nh) + (c - nh);
        else L = (long)skip * (G - nh) + (long)(i - skip) * G + c;
        if (L >= nwg) return false;
        int wgid = (int)L; { const int q = nwg / NXCD, r = nwg % NXCD, xcd = wgid % NXCD, off = wgid / NXCD; wgid = (xcd < r ? xcd * (q + 1) : r * (q + 1) + (xcd - r) * q) + off; }
        const int nig = WGM * nN, gid = wgid / nig, fm = gid * WGM, gsz = (nM - fm) < WGM ? (nM - fm) : WGM;
        u.pm = fm + ((wgid % nig) % gsz); u.pn = (wgid % nig) / gsz;
        int e = 0;
#pragma unroll
        for (int k = 1; k < 8; ++k) e += (u.pm >= ts[k]) ? 1 : 0;
        u.pn += e * NT; return true; }
};

__device__ __forceinline__ unsigned cvt_pk_bf16(float lo, float hi) { unsigned r; asm volatile("v_cvt_pk_bf16_f32 %0, %1, %2" : "=v"(r) : "v"(lo), "v"(hi)); return r; }
__device__ __forceinline__ float bflo(unsigned w) { return __uint_as_float(w << 16); }
__device__ __forceinline__ float bfhi(unsigned w) { return __uint_as_float(w & 0xffff0000u); }
__device__ __forceinline__ u32x4 pack8(const f32x4 v0, const f32x4 v1) { u32x4 w; w.x = cvt_pk_bf16(v0[0], v0[1]); w.y = cvt_pk_bf16(v0[2], v0[3]); w.z = cvt_pk_bf16(v1[0], v1[1]); w.w = cvt_pk_bf16(v1[2], v1[3]); return w; }
__device__ __forceinline__ void mul8(f32x4& v0, f32x4& v1, const u32x4 g) { v0[0] *= bflo(g.x); v0[1] *= bfhi(g.x); v0[2] *= bflo(g.y); v0[3] *= bfhi(g.y); v1[0] *= bflo(g.z); v1[1] *= bfhi(g.z); v1[2] *= bflo(g.w); v1[3] *= bfhi(g.w); }
__device__ __forceinline__ float silu_f(float x) { return x * __builtin_amdgcn_rcpf(1.0f + __builtin_amdgcn_exp2f(-1.44269504f * x)); }

struct EpiPlain {
    static constexpr bool PERM = true, AFTER_DRAIN = false;
    bf16_t* O; int ldc; int ncolt;
    __device__ __forceinline__ void operator()(const f32x4 (&acc)[2][2][4][2], const Unit& u, int wr, int wc, int fr, int fq) const {
        const int row0 = u.pm * BM + wr * 64 + fr; const int tn = ncolt ? (u.pn % ncolt) : u.pn; const int col0 = tn * BM + wc * 32 + 8 * fq;
#pragma unroll
        for (int ai = 0; ai < 2; ++ai)
#pragma unroll
            for (int m = 0; m < 4; ++m) { bf16_t* rowp = O + (size_t)(row0 + ai * HALF + m * 16) * ldc + col0;
#pragma unroll
                for (int bj = 0; bj < 2; ++bj) *(u32x4*)(rowp + bj * HALF) = pack8(acc[ai][bj][m][0], acc[ai][bj][m][1]); }
    }
};
struct EpiMulGate {
    static constexpr bool PERM = true, AFTER_DRAIN = false;
    const bf16_t* G; bf16_t* O; int ldc;
    __device__ __forceinline__ void operator()(const f32x4 (&acc)[2][2][4][2], const Unit& u, int wr, int wc, int fr, int fq) const {
        const int row0 = u.pm * BM + wr * 64 + fr; const int col0 = u.pn * BM + wc * 32 + 8 * fq;
#pragma unroll
        for (int ai = 0; ai < 2; ++ai)
#pragma unroll
            for (int m = 0; m < 4; ++m) { const size_t off = (size_t)(row0 + ai * HALF + m * 16) * ldc + col0;
#pragma unroll
                for (int bj = 0; bj < 2; ++bj) { f32x4 v0 = acc[ai][bj][m][0], v1 = acc[ai][bj][m][1]; const u32x4 g = *(const u32x4*)(G + off + bj * HALF); mul8(v0, v1, g); *(u32x4*)(O + off + bj * HALF) = pack8(v0, v1); } }
    }
};
struct EpiMerge {
    static constexpr bool PERM = true, AFTER_DRAIN = false;
    const bf16_t* G; const bf16_t* M1; bf16_t* O; int ldc;
    __device__ __forceinline__ void operator()(const f32x4 (&acc)[2][2][4][2], const Unit& u, int wr, int wc, int fr, int fq) const {
        const int row0 = u.pm * BM + wr * 64 + fr; const int col0 = u.pn * BM + wc * 32 + 8 * fq;
#pragma unroll
        for (int ai = 0; ai < 2; ++ai)
#pragma unroll
            for (int m = 0; m < 4; ++m) { const size_t off = (size_t)(row0 + ai * HALF + m * 16) * ldc + col0;
#pragma unroll
                for (int bj = 0; bj < 2; ++bj) { f32x4 v0 = acc[ai][bj][m][0], v1 = acc[ai][bj][m][1]; const u32x4 g = *(const u32x4*)(G + off + bj * HALF); const u32x4 q = *(const u32x4*)(M1 + off + bj * HALF); mul8(v0, v1, g);
                    v0[0] += bflo(q.x); v0[1] += bfhi(q.x); v0[2] += bflo(q.y); v0[3] += bfhi(q.y); v1[0] += bflo(q.z); v1[1] += bfhi(q.z); v1[2] += bflo(q.w); v1[3] += bfhi(q.w);
                    *(u32x4*)(O + off + bj * HALF) = pack8(v0, v1); } }
    }
};
struct EpiMerge2 {
    static constexpr bool PERM = true, AFTER_DRAIN = false;
    const bf16_t* R; const bf16_t* G; bf16_t* O; int ldc;
    __device__ __forceinline__ void mid(f32x4 (&acc)[2][2][4][2], const Unit& u, int wr, int wc, int fr, int fq) const {
        asm volatile("" : "+v"(fr));
        const int row0 = u.pm * BM + wr * 64 + fr; const int col0 = u.pn * BM + wc * 32 + 8 * fq;
#pragma unroll
        for (int ai = 0; ai < 2; ++ai)
#pragma unroll
            for (int m = 0; m < 4; ++m) { const size_t off = (size_t)(row0 + ai * HALF + m * 16) * ldc + col0;
#pragma unroll
                for (int bj = 0; bj < 2; ++bj) { const u32x4 r = *(const u32x4*)(R + off + bj * HALF); mul8(acc[ai][bj][m][0], acc[ai][bj][m][1], r); }
                }
    }
    __device__ __forceinline__ void operator()(const f32x4 (&acc)[2][2][4][2], const Unit& u, int wr, int wc, int fr, int fq) const {
        const int row0 = u.pm * BM + wr * 64 + fr; const int col0 = u.pn * BM + wc * 32 + 8 * fq;
#pragma unroll
        for (int ai = 0; ai < 2; ++ai)
#pragma unroll
            for (int m = 0; m < 4; ++m) { const size_t off = (size_t)(row0 + ai * HALF + m * 16) * ldc + col0;
#pragma unroll
                for (int bj = 0; bj < 2; ++bj) { f32x4 v0 = acc[ai][bj][m][0], v1 = acc[ai][bj][m][1]; const u32x4 g = *(const u32x4*)(G + off + bj * HALF); mul8(v0, v1, g); *(u32x4*)(O + off + bj * HALF) = pack8(v0, v1); } }
    }
};
struct EpiSwiglu {
    static constexpr bool PERM = true, AFTER_DRAIN = false;
    bf16_t* O; int ldo; int ncolt;
    __device__ __forceinline__ void operator()(const f32x4 (&acc)[2][2][4][2], const Unit& u, int wr, int wc, int fr, int fq) const {
        const int row0 = u.pm * BM + wr * 64 + fr; const int tn = ncolt ? (u.pn % ncolt) : u.pn; const int col0 = tn * HALF + wc * 32 + 8 * fq;
#pragma unroll
        for (int ai = 0; ai < 2; ++ai)
#pragma unroll
            for (int m = 0; m < 4; ++m) { f32x4 v0, v1;
#pragma unroll
                for (int j = 0; j < 4; ++j) { v0[j] = silu_f(acc[ai][0][m][0][j]) * acc[ai][1][m][0][j]; v1[j] = silu_f(acc[ai][0][m][1][j]) * acc[ai][1][m][1][j]; }
                *(u32x4*)(O + (size_t)(row0 + ai * HALF + m * 16) * ldo + col0) = pack8(v0, v1); }
    }
};
struct EpiResF32 {
    static constexpr bool PERM = false, AFTER_DRAIN = false;
    float* C; const bf16_t* R; int ldc; float alpha;
    __device__ __forceinline__ void operator()(const f32x4 (&acc)[2][2][4][2], const Unit& u, int wr, int wc, int fr, int fq) const {
        const int row0 = u.pm * BM + wr * 64 + fr, col0 = u.pn * BM + wc * 32 + 4 * fq;
        typedef unsigned u32x2v __attribute__((ext_vector_type(2)));
#pragma unroll
        for (int ai = 0; ai < 2; ++ai)
#pragma unroll
            for (int m = 0; m < 4; ++m) { const size_t off = (size_t)(row0 + ai * HALF + m * 16) * ldc + col0;
#pragma unroll
                for (int bj = 0; bj < 2; ++bj)
#pragma unroll
                    for (int n = 0; n < 2; ++n) { const u32x2v h = *(const u32x2v*)(R + off + bj * HALF + n * 16); f32x4 o = acc[ai][bj][m][n];
                        o[0] += alpha * bflo(h.x); o[1] += alpha * bfhi(h.x); o[2] += alpha * bflo(h.y); o[3] += alpha * bfhi(h.y);
                        *(f32x4*)(C + off + bj * HALF + n * 16) = o; } }
    }
};


__device__ __forceinline__ float dpp_ror1(float x) { return __int_as_float(__builtin_amdgcn_update_dpp(0, __float_as_int(x), 0x121, 0xF, 0xF, false)); }
__device__ __forceinline__ float dpp_ror15(float x) { return __int_as_float(__builtin_amdgcn_update_dpp(0, __float_as_int(x), 0x12F, 0xF, 0xF, false)); }
struct EpiProj {
    static constexpr bool PERM = false, AFTER_DRAIN = false;
    static constexpr size_t SBN = (size_t)2048 * 1024;
    bf16_t *YA, *X0T, *ZT, *GA, *GH, *SB; const float *caw, *chw, *chb;
    __device__ __forceinline__ void operator()(const f32x4 (&acc)[2][2][4][2], const Unit& u, int wr, int wc, int fr, int fq) const {
        typedef unsigned u32x2v __attribute__((ext_vector_type(2)));
        const int type = u.pn >> 4, q = u.pn & 15, ch0 = 64 * q + 16 * wc + 4 * fq;
        const int row0 = u.pm * BM + wr * 64 + fr, b = row0 >> 12, p0 = row0 & 4095;
        const size_t cmaj = ((size_t)ch0 * 16 + b) * 4096 + p0;
        const bool top = fr == 0, bot = fr == 15;
        if (type == 0) {
            const f32x4 w0 = *(const f32x4*)(caw + ch0), w1 = *(const f32x4*)(caw + 1024 + ch0), w2 = *(const f32x4*)(caw + 2048 + ch0);
#pragma unroll
            for (int ai = 0; ai < 2; ++ai) {
                f32x4 cu[4];
#pragma unroll
                for (int m = 0; m < 4; ++m)
#pragma unroll
                    for (int j = 0; j < 4; ++j) cu[m][j] = acc[ai][0][m][1][j] * acc[ai][1][m][0][j];
#pragma unroll
                for (int m = 0; m < 4; ++m) { const int dr = ai * HALF + m * 16; const size_t tm = (size_t)(row0 + dr) * 1024 + ch0;
                    const f32x4 ab = acc[ai][0][m][0], x0 = acc[ai][1][m][1]; f32x4 y;
#pragma unroll
                    for (int j = 0; j < 4; ++j) { const float tp = bot ? (m > 0 ? cu[m > 0 ? m - 1 : 0][j] : 0.f) : cu[m][j], tn = top ? (m < 3 ? cu[m < 3 ? m + 1 : 3][j] : 0.f) : cu[m][j];
                        y[j] = ab[j] * (w0[j] * dpp_ror1(tp) + w1[j] * cu[m][j] + w2[j] * dpp_ror15(tn)); }
                    u32x2v w; w.x = cvt_pk_bf16(y[0], y[1]); w.y = cvt_pk_bf16(y[2], y[3]); *(u32x2v*)(YA + tm) = w;
                    const unsigned x01 = cvt_pk_bf16(x0[0], x0[1]), x23 = cvt_pk_bf16(x0[2], x0[3]);
                    X0T[cmaj + dr] = (bf16_t)(x01 & 0xffffu); X0T[cmaj + 65536 + dr] = (bf16_t)(x01 >> 16); X0T[cmaj + 2 * 65536 + dr] = (bf16_t)(x23 & 0xffffu); X0T[cmaj + 3 * 65536 + dr] = (bf16_t)(x23 >> 16);
                    if ((m == 0 && top) || (m == 3 && bot)) { const size_t so = (size_t)(((row0 + dr) >> 6) * 2 + (m == 3 ? 1 : 0)) * 1024 + ch0;
                        w.x = cvt_pk_bf16(ab[0], ab[1]); w.y = cvt_pk_bf16(ab[2], ab[3]); *(u32x2v*)(SB + so) = w;
                        w.x = cvt_pk_bf16(cu[m][0], cu[m][1]); w.y = cvt_pk_bf16(cu[m][2], cu[m][3]); *(u32x2v*)(SB + SBN + so) = w; } }
            }
        } else {
            const f32x4 wv0 = *(const f32x4*)(chw + ch0), wv1 = *(const f32x4*)(chw + 3 * 1024 + ch0), wv2 = *(const f32x4*)(chw + 6 * 1024 + ch0), bv = *(const f32x4*)(chb + ch0);
            const f32x4 wx0 = *(const f32x4*)(chw + 1024 + ch0), wx1 = *(const f32x4*)(chw + 4 * 1024 + ch0), wx2 = *(const f32x4*)(chw + 7 * 1024 + ch0), bx = *(const f32x4*)(chb + 1024 + ch0);
#pragma unroll
            for (int ai = 0; ai < 2; ++ai)
#pragma unroll
                for (int m = 0; m < 4; ++m) { const int dr = ai * HALF + m * 16; const size_t tm = (size_t)(row0 + dr) * 1024 + ch0;
                    const f32x4 v = acc[ai][0][m][0], x1 = acc[ai][0][m][1]; f32x4 ga = acc[ai][1][m][0], gh = acc[ai][1][m][1], pv, px, z;
#pragma unroll
                    for (int j = 0; j < 4; ++j) {
                        const float vp = bot ? (m > 0 ? acc[ai][0][m > 0 ? m - 1 : 0][0][j] : 0.f) : v[j], vn = top ? (m < 3 ? acc[ai][0][m < 3 ? m + 1 : 3][0][j] : 0.f) : v[j];
                        const float xp = bot ? (m > 0 ? acc[ai][0][m > 0 ? m - 1 : 0][1][j] : 0.f) : x1[j], xn = top ? (m < 3 ? acc[ai][0][m < 3 ? m + 1 : 3][1][j] : 0.f) : x1[j];
                        pv[j] = bv[j] + wv0[j] * dpp_ror1(vp) + wv1[j] * v[j] + wv2[j] * dpp_ror15(vn); px[j] = bx[j] + wx0[j] * dpp_ror1(xp) + wx1[j] * x1[j] + wx2[j] * dpp_ror15(xn); z[j] = pv[j] * px[j]; }
                    const unsigned z01 = cvt_pk_bf16(z[0], z[1]), z23 = cvt_pk_bf16(z[2], z[3]);
                    ZT[cmaj + dr] = (bf16_t)(z01 & 0xffffu); ZT[cmaj + 65536 + dr] = (bf16_t)(z01 >> 16); ZT[cmaj + 2 * 65536 + dr] = (bf16_t)(z23 & 0xffffu); ZT[cmaj + 3 * 65536 + dr] = (bf16_t)(z23 >> 16);
                    u32x2v w;
                    if ((m == 0 && top) || (m == 3 && bot)) { const size_t so = (size_t)(((row0 + dr) >> 6) * 2 + (m == 3 ? 1 : 0)) * 1024 + ch0;
                        w.x = cvt_pk_bf16(pv[0], pv[1]); w.y = cvt_pk_bf16(pv[2], pv[3]); *(u32x2v*)(SB + 2 * SBN + so) = w;
                        w.x = cvt_pk_bf16(px[0], px[1]); w.y = cvt_pk_bf16(px[2], px[3]); *(u32x2v*)(SB + 3 * SBN + so) = w;
                        w.x = cvt_pk_bf16(v[0], v[1]); w.y = cvt_pk_bf16(v[2], v[3]); *(u32x2v*)(SB + 4 * SBN + so) = w;
                        w.x = cvt_pk_bf16(x1[0], x1[1]); w.y = cvt_pk_bf16(x1[2], x1[3]); *(u32x2v*)(SB + 5 * SBN + so) = w; }
#pragma unroll
                    for (int j = 0; j < 4; ++j) { const float ea = 1.0f + __builtin_amdgcn_exp2f(ga[j]), eh = 1.0f + __builtin_amdgcn_exp2f(__builtin_fminf(gh[j], 64.0f));
                        ga[j] = eh * __builtin_amdgcn_rcpf(ea); gh[j] = __builtin_amdgcn_rcpf(eh); }
                    w.x = cvt_pk_bf16(ga[0], ga[1]); w.y = cvt_pk_bf16(ga[2], ga[3]); *(u32x2v*)(GA + tm) = w;
                    w.x = cvt_pk_bf16(gh[0], gh[1]); w.y = cvt_pk_bf16(gh[2], gh[3]); *(u32x2v*)(GH + tm) = w; }
        }
    }
};

struct EpiResBf16 {
    static constexpr bool PERM = true, AFTER_DRAIN = false;
    bf16_t* O; const bf16_t* R; int ldc; float alpha;
    __device__ __forceinline__ void operator()(const f32x4 (&acc)[2][2][4][2], const Unit& u, int wr, int wc, int fr, int fq) const {
        const int row0 = u.pm * BM + wr * 64 + fr; const int col0 = u.pn * BM + wc * 32 + 8 * fq;
#pragma unroll
        for (int ai = 0; ai < 2; ++ai)
#pragma unroll
            for (int m = 0; m < 4; ++m) { const size_t off = (size_t)(row0 + ai * HALF + m * 16) * ldc + col0;
#pragma unroll
                for (int bj = 0; bj < 2; ++bj) { f32x4 v0 = acc[ai][bj][m][0], v1 = acc[ai][bj][m][1]; const u32x4 q = *(const u32x4*)(R + off + bj * HALF);
                    v0[0] += alpha * bflo(q.x); v0[1] += alpha * bfhi(q.x); v0[2] += alpha * bflo(q.y); v0[3] += alpha * bfhi(q.y); v1[0] += alpha * bflo(q.z); v1[1] += alpha * bfhi(q.z); v1[2] += alpha * bflo(q.w); v1[3] += alpha * bfhi(q.w);
                    *(u32x4*)(O + off + bj * HALF) = pack8(v0, v1); } }
    }
};

__device__ __forceinline__ float clamp8(float x) { return __builtin_fminf(__builtin_fmaxf(x, -416.f), 416.f); }
typedef unsigned u32x2p __attribute__((ext_vector_type(2)));
__device__ __forceinline__ u32x2p pack8_fp8(const f32x4 v0, const f32x4 v1, float s) { u32x2p w; unsigned a = 0, b = 0;
    a = __builtin_amdgcn_cvt_pk_fp8_f32(clamp8(v0[0] * s), clamp8(v0[1] * s), a, false); a = __builtin_amdgcn_cvt_pk_fp8_f32(clamp8(v0[2] * s), clamp8(v0[3] * s), a, true);
    b = __builtin_amdgcn_cvt_pk_fp8_f32(clamp8(v1[0] * s), clamp8(v1[1] * s), b, false); b = __builtin_amdgcn_cvt_pk_fp8_f32(clamp8(v1[2] * s), clamp8(v1[3] * s), b, true);
    w.x = a; w.y = b; return w; }
__device__ __forceinline__ u32x2p pack8_fp8_ns(const f32x4 v0, const f32x4 v1) { u32x2p w; unsigned a = 0, b = 0;
    a = __builtin_amdgcn_cvt_pk_fp8_f32(clamp8(v0[0]), clamp8(v0[1]), a, false); a = __builtin_amdgcn_cvt_pk_fp8_f32(clamp8(v0[2]), clamp8(v0[3]), a, true);
    b = __builtin_amdgcn_cvt_pk_fp8_f32(clamp8(v1[0]), clamp8(v1[1]), b, false); b = __builtin_amdgcn_cvt_pk_fp8_f32(clamp8(v1[2]), clamp8(v1[3]), b, true);
    w.x = a; w.y = b; return w; }
struct EpiSwiglu8 {
    static constexpr bool PERM = true, AFTER_DRAIN = false;
    unsigned char* O; int ldo; int ncolt; float scale;
    __device__ __forceinline__ void operator()(const f32x4 (&acc)[2][2][4][2], const Unit& u, int wr, int wc, int fr, int fq) const {
        const int row0 = u.pm * BM + wr * 64 + fr; const int tn = ncolt ? (u.pn % ncolt) : u.pn; const int col0 = tn * HALF + wc * 32 + 8 * fq;
#pragma unroll
        for (int ai = 0; ai < 2; ++ai)
#pragma unroll
            for (int m = 0; m < 4; ++m) { f32x4 v0, v1;
#pragma unroll
                for (int j = 0; j < 4; ++j) { const float g0 = acc[ai][0][m][0][j], g1 = acc[ai][0][m][1][j];
                    v0[j] = g0 * __builtin_amdgcn_rcpf(1.0f + __builtin_amdgcn_exp2f(g0)) * acc[ai][1][m][0][j]; v1[j] = g1 * __builtin_amdgcn_rcpf(1.0f + __builtin_amdgcn_exp2f(g1)) * acc[ai][1][m][1][j]; }
                *(u32x2p*)(O + (size_t)(row0 + ai * HALF + m * 16) * ldo + col0) = pack8_fp8_ns(v0, v1); }
    }
};
template <class Epi, class Sched, bool ALIGN_EPI = false, bool SP2 = false, bool F8 = false, bool SPLIT2 = false, bool A2T = false>
__device__ __forceinline__ void gemm_phase(PG8_LAS unsigned char* lds, const Gemm g, const Sched& S, const Epi& E) {
    int tid_ = threadIdx.x; asm volatile("" : "+v"(tid_)); const int tid = tid_, wid = __builtin_amdgcn_readfirstlane(tid >> 6), lane = tid & 63, wr = wid >> 2, wc = wid & 3, fr = lane & 15, fq = lane >> 4;
    const int K = SPLIT2 ? g.K / 2 : g.K, nt = F8 ? g.K / (2 * BK) : g.K / BK, nh = nt / 2; (void)nh;
    const int esz = F8 ? 1 : 2; const int sa_ = g.sa, sb_ = g.sb; (void)sa_; (void)sb_;
    unsigned voffA[2], voffB[2];
#pragma unroll
    for (int i = 0; i < 2; ++i) { int R, C; stage_rc(tid * 16 + i * 8192, R, C); const int Rb = Epi::PERM ? ((R & ~31) + perm32(R & 31)) : R;
        voffA[i] = (unsigned)(R * K * esz + C * 2); voffB[i] = (unsigned)(Rb * K * esz + C * 2); }
    const size_t kstep = (size_t)(BK * 2);
    const size_t hstep = (size_t)HALF * K * esz;
    static_assert(!A2T || (SPLIT2 && SP2 && !F8), "A2T needs the SPLIT2 SP2 bf16 body");
    unsigned voffA2[2], aT[4]; (void)voffA2; (void)aT;
    const size_t ldt = (size_t)g.M * 2;
    if constexpr (A2T) {
#pragma unroll
        for (int i = 0; i < 2; ++i) { const int p = tid * 16 + i * 8192, k = p >> 8, ck = (p >> 4) & 15, grp = (ck >> 1) ^ ((k & 3) | ((k >> 1) & 4)); voffA2[i] = (unsigned)((size_t)k * ldt + (size_t)(16 * grp + 8 * (ck & 1)) * 2); }
        const int q = fr >> 2, p4 = fr & 3;
#pragma unroll
        for (int m = 0; m < 4; ++m) aT[m] = (unsigned)(256 * (8 * fq + q) + 32 * ((4 * wr + m) ^ (q | ((fq & 1) << 2))) + 8 * p4);
    }
    const size_t kstep2 = A2T ? (size_t)BK * ldt : (size_t)(BK * 2), hstepA2 = A2T ? (size_t)256 : hstep, tstepA2 = A2T ? (size_t)512 : 2 * hstep;
    const size_t tstep = 2 * hstep;
    const unsigned ldsw = (unsigned)wid * 1024u;
    const int aoff = lds_byte(wr * 64 + fr, fq * 8), boff = lds_byte(wc * 32 + fr, fq * 8);
#define PG8_SA(b, h) (((b) * 2 + (h)) * HTB)
#define PG8_SB(b, h) ((4 + (b) * 2 + (h)) * HTB)
#define PG8_STAGE(bufoff, gbase, voff) do { _Pragma("unroll") for (int _i = 0; _i < 2; ++_i) \
        __builtin_amdgcn_global_load_lds((const unsigned*)((const char*)(gbase) + (voff)[_i]), (PG8_LAS unsigned*)(lds + (bufoff) + ldsw + _i * 8192), 16, 0, 0); } while (0)
#define PG8_LDA(dst, b, h) do { if constexpr (F8) { _Pragma("unroll") for (int m = 0; m < 4; ++m) { dst##8[m].lo = *(const PG8_LAS i32x4*)(lds + PG8_SA(b, h) + aoff + m * 2048); dst##8[m].hi = *(const PG8_LAS i32x4*)(lds + PG8_SA(b, h) + aoff + m * 2048 + 1024); } } else { \
        if (A2T && trm) { _Pragma("unroll") for (int m = 0; m < 4; ++m) _Pragma("unroll") for (int k = 0; k < 2; ++k) { \
            const s16x4 lo_ = __builtin_amdgcn_ds_read_tr16_b64_v4i16((PG8_LAS s16x4*)(lds + PG8_SA(b, h) + aT[m] + k * 8192)), hi_ = __builtin_amdgcn_ds_read_tr16_b64_v4i16((PG8_LAS s16x4*)(lds + PG8_SA(b, h) + aT[m] + k * 8192 + 1024)); \
            dst[m][k] = __builtin_shufflevector(lo_, hi_, 0, 1, 2, 3, 4, 5, 6, 7); } } else { \
        _Pragma("unroll") for (int m = 0; m < 4; ++m) _Pragma("unroll") for (int k = 0; k < 2; ++k) dst[m][k] = *(const PG8_LAS bf16x8*)(lds + PG8_SA(b, h) + aoff + m * 2048 + k * 1024); } } } while (0)
#define PG8_LDB(dst, b, h) do { if constexpr (F8) { _Pragma("unroll") for (int n = 0; n < 2; ++n) { dst##8[n].lo = *(const PG8_LAS i32x4*)(lds + PG8_SB(b, h) + boff + n * 2048); dst##8[n].hi = *(const PG8_LAS i32x4*)(lds + PG8_SB(b, h) + boff + n * 2048 + 1024); } } else { \
        _Pragma("unroll") for (int n = 0; n < 2; ++n) _Pragma("unroll") for (int k = 0; k < 2; ++k) dst[n][k] = *(const PG8_LAS bf16x8*)(lds + PG8_SB(b, h) + boff + n * 2048 + k * 1024); } } while (0)
#define PG8_MMA(ai, bj, At, Bt) do { __builtin_amdgcn_s_setprio(1); if constexpr (F8) { asm volatile("s_nop 1"); _Pragma("unroll") for (int m = 0; m < 4; ++m) _Pragma("unroll") for (int n = 0; n < 2; ++n) \
            asm volatile("v_mfma_scale_f32_16x16x128_f8f6f4 %0, %1, %2, %0, %3, %4 op_sel_hi:[0,0,0]" : "+v"(acc[ai][bj][m][n]) : "v"(Bt##8[n]), "v"(At##8[m]), "v"(sb_), "v"(sa_)); } else { \
        _Pragma("unroll") for (int m = 0; m < 4; ++m) _Pragma("unroll") for (int n = 0; n < 2; ++n) _Pragma("unroll") for (int k = 0; k < 2; ++k) \
        acc[ai][bj][m][n] = __builtin_amdgcn_mfma_f32_16x16x32_bf16(Bt[n][k], At[m][k], acc[ai][bj][m][n], 0, 0, 0); } __builtin_amdgcn_s_setprio(0); } while (0)
#define PG8_WAIT_V(n) asm volatile("s_waitcnt vmcnt(" #n ")" ::: "memory")
#define PG8_WAIT_L(n) asm volatile("s_waitcnt lgkmcnt(" #n ")" ::: "memory")
#define PG8_BAR __builtin_amdgcn_s_barrier()
#define PG8_SCHED __builtin_amdgcn_sched_barrier(0)
    Unit cur, nxt; int ui = 0;
    if (!S.next(0, cur)) return;
    f32x4 acc[2][2][4][2];
#pragma unroll
    for (int a = 0; a < 2; ++a)
#pragma unroll
        for (int b = 0; b < 2; ++b)
#pragma unroll
            for (int m = 0; m < 4; ++m)
#pragma unroll
                for (int n = 0; n < 2; ++n) acc[a][b][m][n] = (f32x4){0.f, 0.f, 0.f, 0.f};
    bf16x8 At[4][2], B0[2][2], B1[2][2]; i32x8 At8[4], B08[2], B18[2]; (void)At; (void)B0; (void)B1; (void)At8; (void)B08; (void)B18;
    const char* cA = (const char*)g.A + (size_t)cur.pm * tstep; const char* cB = (const char*)g.Bt + (size_t)cur.pn * tstep;
    const char* cA2 = SPLIT2 ? (const char*)g.A2 + (size_t)cur.pm * tstepA2 : cA; const char* cB2 = SPLIT2 ? (const char*)g.B2t + (size_t)cur.pn * tstep : cB; (void)cA2; (void)cB2;
#define PG8_TA(kt) ((SPLIT2 && (kt) >= nh) ? cA2 + (size_t)((kt) - nh) * kstep2 : cA + (size_t)(kt) * kstep)
#define PG8_STAGE_A(b, h, base, sec) do { if constexpr (A2T) { if (sec) PG8_STAGE(PG8_SA(b, h), (base) + (h) * hstepA2, voffA2); else PG8_STAGE(PG8_SA(b, h), (base) + (h) * hstep, voffA); } else PG8_STAGE(PG8_SA(b, h), (base) + (h) * hstep, voffA); } while (0)
#define PG8_TB(kt) ((SPLIT2 && (kt) >= nh) ? cB2 + (size_t)((kt) - nh) * kstep : cB + (size_t)(kt) * kstep)
    S.a_ready(cur);
    if constexpr (SP2) {
        PG8_STAGE(PG8_SB(0, 0), cB, voffB); PG8_STAGE(PG8_SB(0, 1), cB + hstep, voffB); PG8_STAGE(PG8_SA(0, 0), cA, voffA); PG8_STAGE(PG8_SA(0, 1), cA + hstep, voffA);
        if (wr == 1) PG8_BAR;
        PG8_WAIT_V(2); PG8_BAR;
        PG8_STAGE(PG8_SB(1, 0), cB + kstep, voffB); PG8_STAGE(PG8_SA(1, 0), cA + kstep, voffA); PG8_STAGE(PG8_SB(1, 1), cB + hstep + kstep, voffB);
        PG8_WAIT_V(6); PG8_BAR;
    } else {
        PG8_STAGE(PG8_SB(0, 0), cB, voffB); PG8_STAGE(PG8_SA(0, 0), cA, voffA); PG8_STAGE(PG8_SB(0, 1), cB + hstep, voffB); PG8_STAGE(PG8_SA(0, 1), cA + hstep, voffA);
        if (wr == 1) PG8_BAR;
        PG8_WAIT_V(4); PG8_BAR;
        PG8_STAGE(PG8_SB(1, 0), cB + kstep, voffB); PG8_STAGE(PG8_SA(1, 0), cA + kstep, voffA); PG8_STAGE(PG8_SB(1, 1), cB + hstep + kstep, voffB);
        PG8_WAIT_V(6); PG8_BAR;
    }
    for (;;) {
        const bool has_next = S.next(ui + 1, nxt);
        const char* nA = has_next ? (const char*)g.A + (size_t)nxt.pm * tstep : cA; const char* nB = has_next ? (const char*)g.Bt + (size_t)nxt.pn * tstep : cB;
        for (int t = 0; t < nt; t += 2) {
            const bool last = (t == nt - 2);
            if constexpr (SPLIT2) { if (t == nh) E.mid(acc, cur, wr, wc, fr, fq); }
            const char* a1 = PG8_TA(t + 1);
            const char* a2 = last ? nA : PG8_TA(t + 2); const char* b2 = last ? nB : PG8_TB(t + 2);
            const bool s1 = A2T && (t + 1 >= nh), s2 = A2T && !last && (t + 2 >= nh), trm = A2T && (t >= nh); (void)s1; (void)s2; (void)trm;
            const char* a3 = a2 + (s2 ? kstep2 : kstep); const char* b3 = b2 + kstep;
            if (last && has_next) S.a_ready(nxt);
            if constexpr (SP2) {
            PG8_LDB(B0, 0, 0); PG8_LDB(B1, 0, 1); PG8_SCHED; PG8_LDA(At, 0, 0); PG8_STAGE_A(1, 1, a1, s1);
            PG8_WAIT_V(8); PG8_WAIT_L(0); PG8_BAR; PG8_MMA(0, 0, At, B0); PG8_MMA(0, 1, At, B1); PG8_BAR; PG8_SCHED;
            PG8_LDA(At, 0, 1); PG8_STAGE(PG8_SB(0, 0), b2, voffB); PG8_STAGE(PG8_SB(0, 1), b2 + hstep, voffB); PG8_STAGE_A(0, 0, a2, s2);
            PG8_WAIT_V(8); PG8_WAIT_L(0); PG8_BAR; PG8_MMA(1, 0, At, B0); PG8_MMA(1, 1, At, B1); PG8_BAR; PG8_SCHED;
            PG8_LDB(B0, 1, 0); PG8_LDB(B1, 1, 1); PG8_SCHED; PG8_LDA(At, 1, 0); PG8_STAGE_A(0, 1, a2, s2);
            PG8_WAIT_V(8); PG8_WAIT_L(0); PG8_BAR; PG8_MMA(0, 0, At, B0); PG8_MMA(0, 1, At, B1); PG8_BAR; PG8_SCHED;
            PG8_LDA(At, 1, 1); PG8_STAGE(PG8_SB(1, 0), b3, voffB); PG8_STAGE(PG8_SB(1, 1), b3 + hstep, voffB); PG8_STAGE_A(1, 0, a3, s2);
            PG8_WAIT_V(8); PG8_WAIT_L(0); PG8_BAR; PG8_MMA(1, 0, At, B0); PG8_MMA(1, 1, At, B1); PG8_BAR; PG8_SCHED;
            } else {
            PG8_LDB(B0, 0, 0); PG8_SCHED; PG8_LDA(At, 0, 0); PG8_STAGE(PG8_SA(1, 1), a1 + hstep, voffA);
            PG8_WAIT_L(8); PG8_BAR; PG8_WAIT_L(0); PG8_MMA(0, 0, At, B0); PG8_BAR; PG8_SCHED;
            PG8_LDB(B1, 0, 1); PG8_STAGE(PG8_SB(0, 0), b2, voffB);
            PG8_BAR; PG8_WAIT_L(0); PG8_MMA(0, 1, At, B1); PG8_BAR;
            PG8_LDA(At, 0, 1); PG8_STAGE(PG8_SA(0, 0), a2, voffA);
            PG8_BAR; PG8_WAIT_L(0); PG8_MMA(1, 0, At, B0); PG8_BAR; PG8_SCHED;
            PG8_STAGE(PG8_SB(0, 1), b2 + hstep, voffB);
            PG8_WAIT_V(6); PG8_BAR; PG8_MMA(1, 1, At, B1); PG8_BAR;
            PG8_LDB(B0, 1, 0); PG8_SCHED; PG8_LDA(At, 1, 0); PG8_STAGE(PG8_SA(0, 1), a2 + hstep, voffA);
            PG8_WAIT_L(8); PG8_BAR; PG8_WAIT_L(0); PG8_MMA(0, 0, At, B0); PG8_BAR; PG8_SCHED;
            PG8_LDB(B1, 1, 1); PG8_STAGE(PG8_SB(1, 0), b3, voffB);
            PG8_BAR; PG8_WAIT_L(0); PG8_MMA(0, 1, At, B1); PG8_BAR;
            PG8_LDA(At, 1, 1); PG8_STAGE(PG8_SA(1, 0), a3, voffA);
            PG8_BAR; PG8_WAIT_L(0); PG8_MMA(1, 0, At, B0); PG8_BAR; PG8_SCHED;
            PG8_STAGE(PG8_SB(1, 1), b3 + hstep, voffB);
            PG8_WAIT_V(6); PG8_BAR; PG8_MMA(1, 1, At, B1); PG8_BAR;
            }
        }
        if constexpr (F8) asm volatile("s_nop 15\n\ts_nop 15\n\ts_nop 7" ::: "memory");
        if constexpr (ALIGN_EPI) { if (wr == 0) PG8_BAR; }
        if constexpr (!Epi::AFTER_DRAIN) { E(acc, cur, wr, wc, fr, fq); S.done(cur); }
        if (!has_next) break;
#pragma unroll
        for (int a = 0; a < 2; ++a)
#pragma unroll
            for (int b = 0; b < 2; ++b)
#pragma unroll
                for (int m = 0; m < 4; ++m)
#pragma unroll
                    for (int n = 0; n < 2; ++n) acc[a][b][m][n] = (f32x4){0.f, 0.f, 0.f, 0.f};
        cur = nxt; cA = nA; cB = nB; ++ui;
        if constexpr (SPLIT2) { cA2 = (const char*)g.A2 + (size_t)cur.pm * tstepA2; cB2 = (const char*)g.B2t + (size_t)cur.pn * tstep; }
        if constexpr (ALIGN_EPI) { if (wr == 1) PG8_BAR; }
    }
    PG8_WAIT_V(0);
    if constexpr (!ALIGN_EPI) { if (wr == 0) PG8_BAR; }
    PG8_BAR;
    if constexpr (Epi::AFTER_DRAIN) { E.fused(acc, cur, wr, wc, fr, fq, lds, wid, lane); S.done(cur); }
#undef PG8_TA
#undef PG8_STAGE_A
#undef PG8_TB
#undef PG8_SA
#undef PG8_SB
#undef PG8_STAGE
#undef PG8_LDA
#undef PG8_LDB
#undef PG8_MMA
#undef PG8_WAIT_V
#undef PG8_WAIT_L
#undef PG8_BAR
#undef PG8_SCHED
}
}

constexpr int NB = 16, SEQ = 4096, D = 1024, T = NB * SEQ, PROJ = 8192, DFF = 2816, DFE = 3584, NE = 8, NLAYER = 2;
constexpr int CHT = 16384;
constexpr int NCH = T / CHT;
constexpr int CH_ROWS = 2 * CHT + 2048;
constexpr float LN_EPS = 1e-5f;
constexpr float ALPHA = 1.41421356237f;
constexpr int NWAVES = 8, NTHR = 512;

constexpr size_t MiB = 1u << 20;
constexpr size_t WS_CTL = 0, CTL_ZERO_BYTES = 1 * MiB;
constexpr size_t WS_WINT = 1 * MiB;
constexpr size_t WS_WAT = 33 * MiB, WS_WHT = 37 * MiB, WS_WOT = 41 * MiB;
constexpr size_t WS_W13 = 45 * MiB;
constexpr size_t WS_W2 = 56 * MiB;
constexpr size_t WS_H2 = 62 * MiB;
constexpr size_t WS_KFR = 64 * MiB;
constexpr size_t WS_EID = 96 * MiB;
constexpr size_t WS_WGT = 97 * MiB;
constexpr size_t WS_POS = 98 * MiB;
constexpr size_t WS_POS2 = 98 * MiB + 512 * 1024;
constexpr size_t WS_BCNT = 99 * MiB;
constexpr size_t WS_TAB = 99 * MiB + 65536;
constexpr size_t WS_SB = 100 * MiB;
constexpr size_t WS_H8F = 440 * MiB;
constexpr size_t WS_H = 128 * MiB;
constexpr size_t WS_S1 = 256 * MiB, WS_S2 = 384 * MiB, WS_S3 = 512 * MiB, WS_S4 = 640 * MiB, WS_S5 = 768 * MiB, WS_S6 = 896 * MiB;
constexpr size_t WS_ACT0 = 256 * MiB;
constexpr size_t OUT_MW13 = 0, OUT_MW2 = 200 * MiB;
constexpr size_t WS_Y = 256 * MiB;
constexpr size_t WS_HP8 = 528 * MiB;
constexpr size_t WS_ACT8 = 664 * MiB;
constexpr size_t ACT8_BYTES = (size_t)CH_ROWS * DFE;
constexpr float F8_H = 4.f, F8_W13 = 64.f, F8_ACT = 8.f, F8_W2 = 256.f;
constexpr int E8_H = 0x7D7D7D7D, E8_W13 = 0x79797979, E8_ACT = 0x7C7C7C7C, E8_W2 = 0x77777777;
constexpr size_t WS_END = 1024 * MiB;
static_assert(WS_Y + (size_t)NCH * CH_ROWS * D * 2 <= WS_HP8 && WS_HP8 + (size_t)NCH * CH_ROWS * D <= WS_ACT8 && WS_ACT8 + 2 * ACT8_BYTES <= WS_END, "ws map");
constexpr float SWG_W1 = -1.44269504f, SWG_W3 = -0.69314718f * F8_ACT;
constexpr int CW_BAR = 4096;

constexpr int RING_BYTES = 131072, MISC_OFF = RING_BYTES + 320, LDS_BYTES = 147456;

#define GAS __attribute__((address_space(1)))
#define LAS __attribute__((address_space(3)))
typedef unsigned short bf16;
typedef float f32x4 __attribute__((ext_vector_type(4)));
typedef unsigned u32x4 __attribute__((ext_vector_type(4)));
typedef unsigned u32x2 __attribute__((ext_vector_type(2)));
typedef short bf16x8 __attribute__((ext_vector_type(8)));
using pg8::cvt_pk_bf16; using pg8::bflo; using pg8::bfhi;

#define XB_TMO      128
#define XB_XCNT(j)  (256  + 64 * (j))
#define XB_XSUB(j)  (1280 + 64 * (j))
#define XB_XGEN(j)  (2304 + 64 * (j))
#define XB_TOP      3328
#define XB_TOPGEN   3392
#define XCD_BAR_WORDS 3456
#define XB_SPIN_CAP (1u << 18)
__device__ __forceinline__ unsigned xb_ld(unsigned* p)              { return __hip_atomic_load(p, __ATOMIC_RELAXED, __HIP_MEMORY_SCOPE_AGENT); }
__device__ __forceinline__ unsigned xb_add(unsigned* p, unsigned v) { return __hip_atomic_fetch_add(p, v, __ATOMIC_RELAXED, __HIP_MEMORY_SCOPE_AGENT); }
__device__ __forceinline__ unsigned xb_xcc_id() { return (unsigned)__builtin_amdgcn_s_getreg((3 << 11) | 20) & 0xFu; }
#define XB_SPIN(cond, bar) do { unsigned _sp = 0; while (cond) { __builtin_amdgcn_s_sleep(1); \
    if ((++_sp & 255u) == 0u) { if (xb_ld(&(bar)[XB_TMO])) break; if (_sp > XB_SPIN_CAP) { atomicAdd(&(bar)[XB_TMO], 1u); break; } } } } while (0)
struct XcdBarrier { unsigned* bar; unsigned x; volatile LAS unsigned* st; };
__device__ __forceinline__ XcdBarrier xcd_barrier_post(unsigned* bar, volatile LAS unsigned* st) {
    XcdBarrier b; b.bar = bar; b.x = xb_xcc_id(); b.st = st;
    if (threadIdx.x == 0) (void)xb_add(&bar[XB_XCNT(b.x)], 1u);
    return b;
}
__device__ __forceinline__ void xcd_barrier_complete(unsigned* bar, unsigned x, unsigned& nloc, unsigned& nx) {
    const unsigned G = gridDim.x * gridDim.y * gridDim.z;
    unsigned sum, cnt, mine, sp = 0u;
    for (;;) {
        sum = 0u; cnt = 0u; mine = 0u;
#pragma unroll
        for (unsigned j = 0; j < 16; ++j) { const unsigned c = xb_ld(&bar[XB_XCNT(j)]); sum += c; cnt += (c > 0u) ? 1u : 0u; mine = (j == x) ? c : mine; }
        if (sum == G) break;
        __builtin_amdgcn_s_sleep(1);
        if ((++sp & 255u) == 0u) { if (xb_ld(&bar[XB_TMO])) break; if (sp > XB_SPIN_CAP) { atomicAdd(&bar[XB_TMO], 1u); break; } }
    }
    nloc = mine > 0u ? mine : 1u; nx = cnt > 0u ? cnt : 1u;
}
__device__ __forceinline__ void xcd_barrier(const XcdBarrier& b) {
    asm volatile("s_waitcnt vmcnt(0)" ::: "memory");
    __syncthreads();
    if (threadIdx.x == 0) {
        unsigned* bar = b.bar;
        __builtin_amdgcn_s_waitcnt(0);
        unsigned nloc = b.st[0], nx = b.st[1];
        if (nloc == 0u) { xcd_barrier_complete(bar, b.x, nloc, nx); b.st[0] = nloc; b.st[1] = nx; }
        const unsigned old = xb_add(&bar[XB_XSUB(b.x)], 1u);
        const unsigned gen = old / nloc;
        if (old + 1u == (gen + 1u) * nloc) {
            __builtin_amdgcn_fence(__ATOMIC_RELEASE, "agent");
            asm volatile("s_waitcnt vmcnt(0)" ::: "memory");
            const unsigned og = xb_add(&bar[XB_TOP], 1u);
            const unsigned tg = og / nx;
            if (og + 1u == (tg + 1u) * nx) xb_add(&bar[XB_TOPGEN], 1u);
            else XB_SPIN(xb_ld(&bar[XB_TOPGEN]) == tg, bar);
            __builtin_amdgcn_fence(__ATOMIC_ACQUIRE, "agent");
            xb_add(&bar[XB_XGEN(b.x)], 1u);
            asm volatile("s_waitcnt vmcnt(0)" ::: "memory");
        } else {
            XB_SPIN(xb_ld(&bar[XB_XGEN(b.x)]) == gen, bar);
            __builtin_amdgcn_fence(__ATOMIC_ACQUIRE, "agent");
            asm volatile("s_waitcnt vmcnt(0)" ::: "memory");
        }
    }
    __syncthreads();
}

#define GB_CNT(g) (3584 + 64 * (g))
__device__ __forceinline__ void grp_barrier(unsigned* bar, unsigned grp, unsigned nmem, unsigned& gen) {
    asm volatile("s_waitcnt vmcnt(0)" ::: "memory");
    __syncthreads();
    if (threadIdx.x == 0) {
        __builtin_amdgcn_s_waitcnt(0);
        __builtin_amdgcn_fence(__ATOMIC_RELEASE, "agent");
        asm volatile("s_waitcnt vmcnt(0)" ::: "memory");
        (void)xb_add(&bar[GB_CNT(grp)], 1u);
        const unsigned target = (gen + 1u) * nmem;
        XB_SPIN(xb_ld(&bar[GB_CNT(grp)]) < target, bar);
        __builtin_amdgcn_fence(__ATOMIC_ACQUIRE, "agent");
        asm volatile("s_waitcnt vmcnt(0)" ::: "memory");
    }
    ++gen;
    __syncthreads();
}

struct Args { const float* in[28]; float* out; unsigned char* ws; int ph_lo, ph_hi; };
enum { I_X = 0, I_LNING, I_LNINB, I_WIN, I_CAW, I_CHW, I_CHB, I_FW1, I_FB1, I_FFREQ, I_FW2, I_FB2, I_FW3, I_HBIAS, I_WA, I_WH, I_WO, I_LNMG, I_LNMB, I_F1, I_F3, I_F2, I_ROUTER, I_M1, I_M3, I_M2, I_LNFG, I_LNFB };
struct Frame {
    LAS unsigned char* lds;
    int tid, lane, wave, G, gw, NGW;
    const float* const* in; float* out; unsigned char* ws;
    int it0; bool loc;
};
__device__ __forceinline__ float wave_sum(float v) {
#pragma unroll
    for (int o = 1; o < 64; o <<= 1) v += __shfl_xor(v, o);
    return v;
}
__device__ __forceinline__ void unpack8(const u32x4 q, float (&f)[8]) { f[0] = bflo(q.x); f[1] = bfhi(q.x); f[2] = bflo(q.y); f[3] = bfhi(q.y); f[4] = bflo(q.z); f[5] = bfhi(q.z); f[6] = bflo(q.w); f[7] = bfhi(q.w); }
__device__ __forceinline__ u32x4 pack8f(const float (&f)[8]) { u32x4 w; w.x = cvt_pk_bf16(f[0], f[1]); w.y = cvt_pk_bf16(f[2], f[3]); w.z = cvt_pk_bf16(f[4], f[5]); w.w = cvt_pk_bf16(f[6], f[7]); return w; }
__device__ __forceinline__ unsigned f2bf(float f) { return cvt_pk_bf16(f, 0.f) & 0xffffu; }

struct TrItem { const float* W; bf16* WT; int K, N, sel, idx; float f8s; float mul = 1.f; };
__device__ __forceinline__ void tr_load(const TrItem& t, int lane, f32x4 (&v)[8]) {
    const int nblk = t.N / 32, kb = t.idx / nblk, nb = t.idx % nblk, k0 = 64 * kb, n0 = 32 * nb;
#pragma unroll
    for (int i = 0; i < 8; ++i) v[i] = __builtin_nontemporal_load((const f32x4*)(t.W + (size_t)(k0 + 8 * i + (lane >> 3)) * t.N + n0 + 4 * (lane & 7)));
}
__device__ __forceinline__ void tr_store(const TrItem& t, int lane, LAS float* scr, const f32x4 (&v)[8]) {
    const int nblk = t.N / 32, kb = t.idx / nblk, nb = t.idx % nblk, k0 = 64 * kb, n0 = 32 * nb, sel = t.sel;
    int r0 = n0, hi16 = 16;
    if (sel == 0 || sel == 1) r0 = 256 * (n0 >> 7) + 128 * sel + (n0 & 127);
    if (sel == 2) { const int secg = n0 >> 10, cha = n0 & 1023, q = cha >> 6, ch0 = cha & 63;
        const int type = (0xD8 >> secg) & 1, sec = (0xED24 >> (2 * secg)) & 3;
        r0 = 256 * (16 * type + q) + 128 * (sec >> 1) + 32 * (ch0 >> 4) + 16 * (sec & 1); hi16 = 32; }
#pragma unroll
    for (int i = 0; i < 8; ++i) { LAS float* d = scr + (8 * i + (lane >> 3)) * 33 + 4 * (lane & 7); d[0] = v[i].x; d[1] = v[i].y; d[2] = v[i].z; d[3] = v[i].w; }
    asm volatile("s_waitcnt lgkmcnt(0)" ::: "memory");
    const int c = lane & 7;
#pragma unroll
    for (int j = 0; j < 4; ++j) { const int n = (lane >> 3) + 8 * j; const LAS float* s = scr + (8 * c) * 33 + n;
        const float mu = t.mul; u32x4 o; o.x = cvt_pk_bf16(s[0 * 33] * mu, s[1 * 33] * mu); o.y = cvt_pk_bf16(s[2 * 33] * mu, s[3 * 33] * mu); o.z = cvt_pk_bf16(s[4 * 33] * mu, s[5 * 33] * mu); o.w = cvt_pk_bf16(s[6 * 33] * mu, s[7 * 33] * mu);
        if (t.f8s != 0.f) { const float f = t.f8s; unsigned a = 0, b = 0;
            a = __builtin_amdgcn_cvt_pk_fp8_f32(s[0 * 33] * f, s[1 * 33] * f, a, false); a = __builtin_amdgcn_cvt_pk_fp8_f32(s[2 * 33] * f, s[3 * 33] * f, a, true);
            b = __builtin_amdgcn_cvt_pk_fp8_f32(s[4 * 33] * f, s[5 * 33] * f, b, false); b = __builtin_amdgcn_cvt_pk_fp8_f32(s[6 * 33] * f, s[7 * 33] * f, b, true);
            *(u32x2*)((unsigned char*)t.WT + (size_t)(r0 + (n & 15) + hi16 * (n >> 4)) * t.K + k0 + 8 * c) = (u32x2){a, b}; }
        else *(u32x4*)(t.WT + (size_t)(r0 + (n & 15) + hi16 * (n >> 4)) * t.K + k0 + 8 * c) = o; }
    asm volatile("s_waitcnt lgkmcnt(0)" ::: "memory");
}
#define TR_LOOP(NIT, DEC) for (int it_ = F.gw; it_ < (NIT); it_ += 2 * F.NGW) { const TrItem ta_ = DEC(it_); const bool hb_ = it_ + F.NGW < (NIT); const TrItem tb_ = DEC(hb_ ? it_ + F.NGW : it_); \
        f32x4 va_[8], vb_[8]; tr_load(ta_, F.lane, va_); if (hb_) tr_load(tb_, F.lane, vb_); tr_store(ta_, F.lane, scr, va_); if (hb_) tr_store(tb_, F.lane, scr, vb_); }

__device__ __forceinline__ void ln_apply(f32x4 (&v)[4], const f32x4 (&g)[4], const f32x4 (&b)[4]) {
    float s = 0.f;
#pragma unroll
    for (int j = 0; j < 4; ++j) s += (v[j].x + v[j].y) + (v[j].z + v[j].w);
    const float mean = wave_sum(s) * (1.f / D); float s2 = 0.f;
#pragma unroll
    for (int j = 0; j < 4; ++j) { v[j] = v[j] - mean; s2 += (v[j].x * v[j].x + v[j].y * v[j].y) + (v[j].z * v[j].z + v[j].w * v[j].w); }
    const float rstd = 1.f / sqrtf(wave_sum(s2) * (1.f / D) + LN_EPS);
#pragma unroll
    for (int j = 0; j < 4; ++j) v[j] = v[j] * rstd * g[j] + b[j];
}
template <int R, bool LGB = false> __device__ __forceinline__ void ln_rows(f32x4 (&v)[R][4], const f32x4 (&g)[4], const f32x4 (&b)[4], const LAS f32x4* gl = nullptr, int lane = 0) {
    float s[R];
#pragma unroll
    for (int r = 0; r < R; ++r) { s[r] = 0.f;
#pragma unroll
        for (int j = 0; j < 4; ++j) s[r] += (v[r][j].x + v[r][j].y) + (v[r][j].z + v[r][j].w); }
#pragma unroll
    for (int o = 1; o < 64; o <<= 1)
#pragma unroll
        for (int r = 0; r < R; ++r) s[r] += __shfl_xor(s[r], o);
    float q[R];
#pragma unroll
    for (int r = 0; r < R; ++r) { const float mean = s[r] * (1.f / D); q[r] = 0.f;
#pragma unroll
        for (int j = 0; j < 4; ++j) { v[r][j] = v[r][j] - mean; q[r] += (v[r][j].x * v[r][j].x + v[r][j].y * v[r][j].y) + (v[r][j].z * v[r][j].z + v[r][j].w * v[r][j].w); } }
#pragma unroll
    for (int o = 1; o < 64; o <<= 1)
#pragma unroll
        for (int r = 0; r < R; ++r) q[r] += __shfl_xor(q[r], o);
#pragma unroll
    for (int r = 0; r < R; ++r) { const float rstd = 1.f / sqrtf(q[r] * (1.f / D) + LN_EPS);
#pragma unroll
        for (int j = 0; j < 4; ++j) { if (LGB) v[r][j] = v[r][j] * rstd * gl[lane + 64 * j] + gl[256 + lane + 64 * j]; else v[r][j] = v[r][j] * rstd * g[j] + b[j]; } }
}
__device__ __forceinline__ void store_row_bf16(bf16* orow, int lane, const f32x4 (&v)[4]) {
    u32x2* o8 = (u32x2*)orow + lane;
#pragma unroll
    for (int j = 0; j < 4; ++j) { u32x2 w; w.x = cvt_pk_bf16(v[j].x, v[j].y); w.y = cvt_pk_bf16(v[j].z, v[j].w); o8[64 * j] = w; }
}

__device__ __forceinline__ void ph_prologue_a(Frame& F) {
    LAS float* scr = (LAS float*)(F.lds + F.wave * 16384);
    unsigned char* ws = F.ws;
    constexpr int I_WIN_N = (D / 64) * (PROJ / 32), I_SQ = (D / 64) * (D / 32), I_F13 = (D / 64) * (DFF / 32), I_F2N = (DFF / 64) * (D / 32);
    constexpr int NITEMS = 2 * I_WIN_N + 6 * I_SQ + 2 * I_F13 + I_F2N;
    auto dec = [&](int it) -> TrItem { int r = it; TrItem t;
        if (r < 2 * I_WIN_N) { const int l = r / I_WIN_N; t = TrItem{F.in[I_WIN] + (size_t)l * D * PROJ, (bf16*)(ws + WS_WINT) + (size_t)l * PROJ * D, D, PROJ, 2, r % I_WIN_N, 0.f, ((r % I_WIN_N) % (PROJ / 32)) >= 6 * (D / 32) ? SWG_W1 : 1.f}; return t; }     r -= 2 * I_WIN_N;
        if (r < 6 * I_SQ) { const int w = r / I_SQ, l = w & 1, which = w >> 1; const float* src = F.in[which == 0 ? I_WA : (which == 1 ? I_WH : I_WO)] + (size_t)l * D * D;
            bf16* dst = (bf16*)(ws + (which == 0 ? WS_WAT : (which == 1 ? WS_WHT : WS_WOT))) + (size_t)l * D * D; t = TrItem{src, dst, D, D, -1, r % I_SQ, 0.f}; return t; } r -= 6 * I_SQ;
        if (r < 2 * I_F13) { const int sel = r / I_F13; t = TrItem{F.in[sel == 0 ? I_F1 : I_F3], (bf16*)(ws + WS_W13), D, DFF, sel, r % I_F13, F8_W13 * (sel == 0 ? SWG_W1 : SWG_W3)}; return t; } r -= 2 * I_F13;
        t = TrItem{F.in[I_F2], (bf16*)(ws + WS_W2), DFF, D, -1, r, F8_W2}; return t; };
    TR_LOOP(NITEMS, dec)
    { f32x4 g[4], b[4];
#pragma unroll
      for (int j = 0; j < 4; ++j) { g[j] = ((const f32x4*)F.in[I_LNING])[F.lane + 64 * j]; b[j] = ((const f32x4*)F.in[I_LNINB])[F.lane + 64 * j]; }
      for (int m0 = F.gw * 4; m0 < T; m0 += F.NGW * 4) { f32x4 v[4][4];
#pragma unroll
          for (int r = 0; r < 4; ++r) { const f32x4* xr = (const f32x4*)(F.in[I_X] + (size_t)(m0 + r) * D) + F.lane;
#pragma unroll
              for (int j = 0; j < 4; ++j) v[r][j] = __builtin_nontemporal_load(&xr[64 * j]); }
          ln_rows<4>(v, g, b);
#pragma unroll
          for (int r = 0; r < 4; ++r) store_row_bf16((bf16*)(ws + WS_H) + (size_t)(m0 + r) * D, F.lane, v[r]); } }
    for (int it = F.gw; it < NLAYER * SEQ; it += F.NGW) {
        const int l = it / SEQ, t = it % SEQ, u = F.lane;
        const float* w1 = F.in[I_FW1] + (size_t)l * 33 * 64; const float* w2 = F.in[I_FW2] + (size_t)l * 64 * 64;
        const float fr = F.in[I_FFREQ][l * 64 + u];
        const float tn = (float)t / (float)(SEQ - 1);
        float a = tn * w1[u];
        for (int k = 0; k < 16; ++k) { const float band = 1e-4f + (15.0f - 1e-4f) * (float)k / 15.0f; const float rev = band * ((float)t / (float)SEQ);
            const float fr_ = rev - floorf(rev);
            a += __builtin_amdgcn_cosf(fr_) * w1[(1 + k) * 64 + u] - __builtin_amdgcn_sinf(fr_) * w1[(17 + k) * 64 + u]; }
        const float h1 = __sinf(fr * (a + F.in[I_FB1][l * 64 + u]));
        float a2 = 0.f;
        for (int k = 0; k < 64; ++k) a2 += __shfl(h1, k) * w2[k * 64 + u];
        const float h2 = __sinf(fr * (a2 + F.in[I_FB2][l * 64 + u]));
        ((float*)(ws + WS_H2))[(size_t)it * 64 + u] = h2;
    }
}
__device__ __forceinline__ void ph_prologue_b(Frame& F) {
    unsigned char* ws = F.ws;
    const float maxd = logf(1e-2f) / 0.3f, mind = logf(1e-2f) / 1.5f;
    LAS float* tile = (LAS float*)F.lds;
    for (int grp = blockIdx.x; grp < NLAYER * 2 * D / NWAVES; grp += F.G) {
        const int it = grp * NWAVES + F.wave;
        const int l = it / (2 * D), col = it % (2 * D), dir = col / D, c = col % D;
        const float* w3 = F.in[I_FW3] + (size_t)l * 64 * 2 * D + col;
        float w[64];
#pragma unroll
        for (int k = 0; k < 64; ++k) w[k] = __int_as_float(__builtin_amdgcn_readfirstlane(__float_as_int(w3[(size_t)k * 2 * D])));
        const float delta = fabsf(mind + (maxd - mind) * (float)c / (float)(D - 1));
        const float* h2 = (const float*)(ws + WS_H2) + (size_t)l * SEQ * 64;
        float* tmp = (float*)(ws + WS_S1) + (size_t)it * SEQ;
        float ss = 0.f;
        f32x4 pre[8];
#pragma unroll
        for (int i = 0; i < 8; ++i) { const int idx = F.tid + NTHR * i; pre[i] = *(const f32x4*)(h2 + (size_t)(idx >> 4) * 64 + 4 * (idx & 15)); }
#pragma unroll 1
        for (int ch = 0; ch < 16; ++ch) {
            __syncthreads();
#pragma unroll
            for (int i = 0; i < 8; ++i) { const int idx = F.tid + NTHR * i; *(LAS f32x4*)(tile + (idx >> 4) * 68 + 4 * (idx & 15)) = pre[i]; }
            __syncthreads();
            { const int nch = (ch < 15) ? ch + 1 : ch;
#pragma unroll
              for (int i = 0; i < 8; ++i) { const int idx = F.tid + NTHR * i; pre[i] = *(const f32x4*)(h2 + (size_t)(256 * nch + (idx >> 4)) * 64 + 4 * (idx & 15)); } }
#pragma unroll
            for (int jj = 0; jj < 4; ++jj) { const int row = F.lane + 64 * jj, t = 256 * ch + row; float dot = 0.f;
#pragma unroll
                for (int k4 = 0; k4 < 16; ++k4) { const f32x4 h = *(const LAS f32x4*)(tile + row * 68 + 4 * k4); dot += h.x * w[4 * k4] + h.y * w[4 * k4 + 1] + h.z * w[4 * k4 + 2] + h.w * w[4 * k4 + 3]; }
                const float val = dot * expf(-((float)t / (float)(SEQ - 1)) * delta); tmp[t] = val; ss += val * val; asm volatile("" ::: "memory"); }
        }
        ss = wave_sum(ss);
        const float scale = 1.0f / sqrtf(ss + 1e-6f);
        bf16* rv = (bf16*)(ws + WS_KFR) + ((size_t)l * D + c) * 8192;
        const float hb = F.in[I_HBIAS][l * D + c];
        asm volatile("s_waitcnt vmcnt(0)" ::: "memory");
#pragma unroll 4
        for (int i = 0; i < 64; ++i) { const int t = F.lane + 64 * i; float val = __uint_as_float(__hip_atomic_load((unsigned*)tmp + t, __ATOMIC_RELAXED, __HIP_MEMORY_SCOPE_AGENT)) * scale;
            if (dir == 0) { if (t == 0) val += hb; rv[4095 - t] = (bf16)f2bf(val); }
            else { if (t > 0) rv[4095 + t] = (bf16)f2bf(val); else rv[8191] = 0; } }
    }
}

__device__ __forceinline__ u32x4 ldrow(const bf16* p, bool ok) { u32x4 q = (u32x4){0u, 0u, 0u, 0u}; if (ok) q = *(const u32x4*)p; return q; }
__device__ __forceinline__ void ld8f(const float* p, float (&f)[8]) { const f32x4 a = *(const f32x4*)p, b = *(const f32x4*)(p + 4); f[0] = a.x; f[1] = a.y; f[2] = a.z; f[3] = a.w; f[4] = b.x; f[5] = b.y; f[6] = b.z; f[7] = b.w; }
__device__ __forceinline__ void ph_fix(Frame& F, int l) {
    unsigned char* ws = F.ws;
    const bf16* SB = (const bf16*)(ws + WS_SB); bf16* YA = (bf16*)F.out; bf16* ZT = (bf16*)(ws + WS_S4);
    constexpr size_t SBN = (size_t)(T / 32) * D;
    const float* caw = F.in[I_CAW] + (size_t)l * 3 * D; const float* chw = F.in[I_CHW] + (size_t)l * 3 * 3 * D;
    const int k0 = F.loc ? 128 * (int)(blockIdx.x & 7) + 4 * (int)(blockIdx.x >> 3) + F.wave : F.gw, kend = F.loc ? (F.wave < 4 ? k0 + 1 : k0) : T / 64;
    for (int k = k0; k < kend; k += F.NGW) {
        const int t = 64 * k + 63;
        if (((t + 1) & (SEQ - 1)) == 0) continue;
        const int b = t >> 12, p = t & (SEQ - 1);
#pragma unroll 1
        for (int h = 0; h < 2; ++h) {
            const int c0 = 8 * (F.lane + 64 * h); const size_t s0 = (size_t)(2 * k + 1) * D + c0, s1 = (size_t)(2 * k + 2) * D + c0;
            { float ab0[8], ab1[8], cu0[8], cu1[8], w0[8], w2[8], y0[8], y1[8];
              unpack8(*(const u32x4*)(SB + s0), ab0); unpack8(*(const u32x4*)(SB + s1), ab1); unpack8(*(const u32x4*)(SB + SBN + s0), cu0); unpack8(*(const u32x4*)(SB + SBN + s1), cu1);
              ld8f(caw + c0, w0); ld8f(caw + 2 * D + c0, w2);
              unpack8(*(const u32x4*)(YA + (size_t)t * D + c0), y0); unpack8(*(const u32x4*)(YA + (size_t)(t + 1) * D + c0), y1);
#pragma unroll
              for (int j = 0; j < 8; ++j) { y0[j] += ab0[j] * w2[j] * cu1[j]; y1[j] += ab1[j] * w0[j] * cu0[j]; }
              *(u32x4*)(YA + (size_t)t * D + c0) = pack8f(y0); *(u32x4*)(YA + (size_t)(t + 1) * D + c0) = pack8f(y1); }
            { float pv0[8], pv1[8], px0[8], px1[8], v0[8], v1[8], x0[8], x1[8], wv0[8], wv2[8], wx0[8], wx2[8];
              unpack8(*(const u32x4*)(SB + 2 * SBN + s0), pv0); unpack8(*(const u32x4*)(SB + 2 * SBN + s1), pv1); unpack8(*(const u32x4*)(SB + 3 * SBN + s0), px0); unpack8(*(const u32x4*)(SB + 3 * SBN + s1), px1);
              unpack8(*(const u32x4*)(SB + 4 * SBN + s0), v0); unpack8(*(const u32x4*)(SB + 4 * SBN + s1), v1); unpack8(*(const u32x4*)(SB + 5 * SBN + s0), x0); unpack8(*(const u32x4*)(SB + 5 * SBN + s1), x1);
              ld8f(chw + c0, wv0); ld8f(chw + 6 * D + c0, wv2); ld8f(chw + D + c0, wx0); ld8f(chw + 7 * D + c0, wx2);
#pragma unroll
              for (int j = 0; j < 8; ++j) { const float z0 = (pv0[j] + wv2[j] * v1[j]) * (px0[j] + wx2[j] * x1[j]), z1 = (pv1[j] + wv0[j] * v0[j]) * (px1[j] + wx0[j] * x0[j]);
                  bf16* zp = ZT + ((size_t)(c0 + j) * NB + b) * SEQ + p; const unsigned zz = cvt_pk_bf16(z0, z1);
                  zp[0] = (bf16)(zz & 0xffffu); zp[1] = (bf16)(zz >> 16); } }
        }
    }
}

constexpr int CONV_CS = 16448;
__device__ __forceinline__ bf16x8 conv_ldfrag(const LAS unsigned char* p) { const u32x2 lo = *(const LAS u32x2*)p, hi = *(const LAS u32x2*)(p + 8); return __builtin_bit_cast(bf16x8, (u32x4){lo.x, lo.y, hi.x, hi.y}); }
__device__ __forceinline__ void ph_conv(Frame& F, int l) {
    unsigned char* ws = F.ws;
    const bf16* ZT = (const bf16*)(ws + WS_S4); const bf16* X0T = (const bf16*)(ws + WS_S3);
    const float* chw = F.in[I_CHW] + (size_t)l * 3 * 3 * D; const float* chb = F.in[I_CHB] + (size_t)l * 3 * D;
    const int lane = F.lane, r = lane & 15, g = lane >> 4, mcopy = (3 - r) & 3;
    typedef unsigned u32x4u __attribute__((ext_vector_type(4), aligned(4)));
    bf16x8 B0[8], B1[8];
#define CONV_LDB(dst, p) do { \
    asm volatile("global_load_dwordx4 %0, %1, off" : "=&v"(dst[0]) : "v"(p)); asm volatile("global_load_dwordx4 %0, %1, off offset:64" : "=&v"(dst[1]) : "v"(p)); \
    asm volatile("global_load_dwordx4 %0, %1, off offset:128" : "=&v"(dst[2]) : "v"(p)); asm volatile("global_load_dwordx4 %0, %1, off offset:192" : "=&v"(dst[3]) : "v"(p)); \
    asm volatile("global_load_dwordx4 %0, %1, off offset:256" : "=&v"(dst[4]) : "v"(p)); asm volatile("global_load_dwordx4 %0, %1, off offset:320" : "=&v"(dst[5]) : "v"(p)); \
    asm volatile("global_load_dwordx4 %0, %1, off offset:384" : "=&v"(dst[6]) : "v"(p)); asm volatile("global_load_dwordx4 %0, %1, off offset:448" : "=&v"(dst[7]) : "v"(p)); } while (0)
#define CONV_WAITB(dst) asm volatile("s_waitcnt vmcnt(0)" : "+v"(dst[0]), "+v"(dst[1]), "+v"(dst[2]), "+v"(dst[3]), "+v"(dst[4]), "+v"(dst[5]), "+v"(dst[6]), "+v"(dst[7]))
#define CONV_BLOCK(Bc, blk) do { const LAS unsigned char* fb = fbase + 512 * (blk); \
    _Pragma("unroll") for (int q = 0; q < 8; ++q) { \
        _Pragma("unroll") for (int ti = 15; ti >= 14; --ti) acc[ti] = __builtin_amdgcn_mfma_f32_16x16x32_bf16(Fw[(2 * q - ti) & 15], Bc[q], acc[ti], 0, 0, 0); \
        Fw[(2 * q + 1) & 15] = conv_ldfrag(fb + 32 * (2 * q + 1)); Fw[(2 * q + 2) & 15] = conv_ldfrag(fb + 32 * (2 * q + 2));     \
        _Pragma("unroll") for (int ti = 13; ti >= 0; --ti) acc[ti] = __builtin_amdgcn_mfma_f32_16x16x32_bf16(Fw[(2 * q - ti) & 15], Bc[q], acc[ti], 0, 0, 0); \
        __builtin_amdgcn_sched_group_barrier(0x008, 2, 0); __builtin_amdgcn_sched_group_barrier(0x100, 2, 0); __builtin_amdgcn_sched_group_barrier(0x008, 14, 0); } } while (0)
    { const bf16* zp = ZT + ((size_t)blockIdx.x * NB + r) * SEQ + 8 * g; CONV_LDB(B0, zp); }
    for (int c = blockIdx.x; c < D; c += F.G) {
        const bf16* rv = (const bf16*)(ws + WS_KFR) + ((size_t)l * D + c) * 8192;
        for (int q = F.tid; q < 1024; q += NTHR) {
            const u32x4 a = *(const u32x4*)(rv + 8 * q); u32x2 b = (u32x2){0u, 0u}; if (q < 1023) b = *(const u32x2*)(rv + 8 * q + 8);
            const unsigned d0 = a.x, d1 = a.y, d2 = a.z, d3 = a.w, d4 = b.x, d5 = b.y;
            *(LAS u32x4*)(F.lds + 0 * CONV_CS + 16 * q) = (u32x4){d0, d1, d2, d3};
            *(LAS u32x4*)(F.lds + 1 * CONV_CS + 16 * q) = (u32x4){__builtin_amdgcn_alignbit(d1, d0, 16), __builtin_amdgcn_alignbit(d2, d1, 16), __builtin_amdgcn_alignbit(d3, d2, 16), __builtin_amdgcn_alignbit(d4, d3, 16)};
            *(LAS u32x4*)(F.lds + 2 * CONV_CS + 16 * q) = (u32x4){d1, d2, d3, d4};
            *(LAS u32x4*)(F.lds + 3 * CONV_CS + 16 * q) = (u32x4){__builtin_amdgcn_alignbit(d2, d1, 16), __builtin_amdgcn_alignbit(d3, d2, 16), __builtin_amdgcn_alignbit(d4, d3, 16), __builtin_amdgcn_alignbit(d5, d4, 16)};
        }
        __syncthreads();
        const bf16* zrow = ZT + ((size_t)c * NB + r) * SEQ + 8 * g;
#pragma unroll 1
        for (int tbk = 0; tbk < 2; ++tbk) {
            const int tb = 256 * (2 * F.wave + tbk);
            const LAS unsigned char* fbase = F.lds + mcopy * CONV_CS + 2 * (4092 - tb - 4 * (r >> 2) + 8 * g);
            f32x4 acc[16];
#pragma unroll
            for (int i = 0; i < 16; ++i) acc[i] = (f32x4){0.f, 0.f, 0.f, 0.f};
            bf16x8 Fw[16];
#pragma unroll
            for (int u = -15; u <= 0; ++u) Fw[u & 15] = conv_ldfrag(fbase + 32 * u);
            CONV_WAITB(B0);
#pragma unroll 1
            for (int b2 = 0; b2 < 7; ++b2) {
                { const bf16* zp = zrow + 256 * (2 * b2 + 1); CONV_LDB(B1, zp); }
                CONV_BLOCK(B0, 2 * b2);
                CONV_WAITB(B1);
                { const bf16* zp = zrow + 256 * (2 * b2 + 2); CONV_LDB(B0, zp); }
                CONV_BLOCK(B1, 2 * b2 + 1);
                CONV_WAITB(B0);
            }
            { const bf16* zp = zrow + 256 * 15; CONV_LDB(B1, zp); }
            CONV_BLOCK(B0, 14);
            CONV_WAITB(B1);
            { const int cn = (c + F.G < D) ? c + F.G : c;
              const bf16* zp = (tbk == 0) ? zrow : ZT + ((size_t)cn * NB + r) * SEQ + 8 * g; CONV_LDB(B0, zp); }
            CONV_BLOCK(B1, 15);
            const bf16* xrow = X0T + ((size_t)c * NB + r) * SEQ + tb + 4 * g; bf16* orow = (bf16*)F.out + (size_t)T * D + ((size_t)c * NB + r) * SEQ + tb + 4 * g;
            const float xw0 = chw[2 * D + c], xw1 = chw[5 * D + c], xw2 = chw[8 * D + c], xb = chb[2 * D + c];
#pragma unroll
            for (int ti = 0; ti < 16; ++ti) { const int t0 = tb + 16 * ti + 4 * g; const u32x4u x = *(const u32x4u*)(xrow + 16 * ti - 2);
                float e[6]; e[1] = bflo(x.y); e[2] = bfhi(x.y); e[3] = bflo(x.z); e[4] = bfhi(x.z);
                e[0] = (t0 > 0) ? bfhi(x.x) : 0.f; e[5] = (t0 + 4 < SEQ) ? bflo(x.w) : 0.f;
                float y[4];
#pragma unroll
                for (int k = 0; k < 4; ++k) y[k] = (xb + xw0 * e[k] + xw1 * e[k + 1] + xw2 * e[k + 2]) * acc[ti][k];
                u32x2 o; o.x = cvt_pk_bf16(y[0], y[1]); o.y = cvt_pk_bf16(y[2], y[3]);
                *(u32x2*)(orow + 16 * ti) = o; }
        }
        __syncthreads();
    }
    CONV_WAITB(B0);
#undef CONV_LDB
#undef CONV_WAITB
#undef CONV_BLOCK
}

__device__ __forceinline__ void ph_tr(Frame& F) {
    unsigned char* ws = F.ws;
    const bf16* src = (const bf16*)F.out + (size_t)T * D; bf16* dst = (bf16*)(ws + WS_S3);
    LAS unsigned char* scr = F.lds + F.wave * 8192;
    const int lane = F.lane;
    for (int it = F.gw; it < NB * (SEQ / 64) * (D / 64); it += F.NGW) {
        const int ct = it % (D / 64), tt = (it / (D / 64)) % (SEQ / 64), b = it / ((D / 64) * (SEQ / 64));
        const int c0 = ct * 64, t0 = tt * 64;
#pragma unroll
        for (int k = 0; k < 8; ++k) { const int idx = lane + 64 * k, crow = idx >> 3, q = idx & 7;
            const u32x4 v = *(const u32x4*)(src + ((size_t)(c0 + crow) * NB + b) * SEQ + t0 + 8 * q);
            const unsigned w[4] = {v.x, v.y, v.z, v.w};
#pragma unroll
            for (int i = 0; i < 8; ++i) { const unsigned short h = (unsigned short)((i & 1) ? (w[i >> 1] >> 16) : (w[i >> 1] & 0xffffu));
                *(LAS unsigned short*)(scr + (8 * q + i) * 128 + 2 * (crow ^ (q << 3))) = h; } }
        asm volatile("s_waitcnt lgkmcnt(0)" ::: "memory");
#pragma unroll
        for (int k = 0; k < 8; ++k) { const int idx = lane + 64 * k, t = idx >> 3, ch = idx & 7;
            const u32x4 v = *(const LAS u32x4*)(scr + t * 128 + 16 * (ch ^ ((t >> 3) & 7)));
            *(u32x4*)(dst + ((size_t)b * SEQ + t0 + t) * D + c0 + 8 * ch) = v; }
        asm volatile("s_waitcnt lgkmcnt(0)" ::: "memory");
    }
}

template <int MODE> __device__ __forceinline__ void ph_ln(Frame& F, const float* gsrc, const float* bsrc) {
    unsigned char* ws = F.ws;
    const bf16* S = (const bf16*)F.out; bf16* H = (bf16*)(ws + WS_H);
    f32x4 g[4], b[4];
    __syncthreads();
    LAS f32x4* gl = (LAS f32x4*)(F.lds + 4096);
    if (MODE == 1) { if (F.tid < 256) { gl[F.tid] = ((const f32x4*)gsrc)[F.tid]; gl[256 + F.tid] = ((const f32x4*)bsrc)[F.tid]; } }
    else {
#pragma unroll
        for (int j = 0; j < 4; ++j) { g[j] = ((const f32x4*)gsrc)[F.lane + 64 * j]; b[j] = ((const f32x4*)bsrc)[F.lane + 64 * j]; } }
    LAS int* leid = (LAS int*)(F.lds);
    constexpr int R = 4;
    const LAS f32x4* rt = (const LAS f32x4*)(F.lds + 16384);
    if (MODE == 1) { const float* Rg = F.in[I_ROUTER]; LAS float* rtw = (LAS float*)(F.lds + 16384);
        for (int idx = F.tid; idx < D * NE; idx += NTHR) rtw[(idx & 7) * D + (idx >> 3)] = Rg[idx];
        __syncthreads(); }
    for (int it = F.it0; it < T / 256; it += F.G) {
        if (MODE == 1) __syncthreads();
        u32x2 nq[R][4];
#pragma unroll
        for (int r = 0; r < R; ++r) { const u32x2* xr = (const u32x2*)(S + (size_t)(it * 256 + F.wave * 32 + r) * D) + F.lane;
#pragma unroll
            for (int j = 0; j < 4; ++j) if (MODE != 1) nq[r][j] = xr[64 * j]; }
        for (int rr = 0; rr < 32; rr += R) {
            const int tl0 = F.wave * 32 + rr, m0 = it * 256 + tl0;
            f32x4 v[R][4];
#pragma unroll
            for (int r = 0; r < R; ++r)
#pragma unroll
                for (int j = 0; j < 4; ++j) { u32x2 q; if (MODE != 1) q = nq[r][j]; else q = ((const u32x2*)(S + (size_t)(m0 + r) * D) + F.lane)[64 * j]; v[r][j] = (f32x4){bflo(q.x), bfhi(q.x), bflo(q.y), bfhi(q.y)}; }
            if (MODE != 1) { const int nr = (rr + R < 32) ? rr + R : rr;
#pragma unroll
              for (int r = 0; r < R; ++r) { const u32x2* xr = (const u32x2*)(S + (size_t)(it * 256 + F.wave * 32 + nr + r) * D) + F.lane;
#pragma unroll
                  for (int j = 0; j < 4; ++j) nq[r][j] = xr[64 * j]; } }
            ln_rows<R, MODE == 1>(v, g, b, gl, F.lane);
#pragma unroll
            for (int r = 0; r < R; ++r) store_row_bf16(H + (size_t)(m0 + r) * D, F.lane, v[r]);
            if (MODE == 2) {
#pragma unroll
                for (int r = 0; r < R; ++r) { unsigned* h8 = (unsigned*)(ws + WS_H8F + (size_t)(m0 + r) * D) + F.lane;
#pragma unroll
                    for (int j = 0; j < 4; ++j) { unsigned a = 0; a = __builtin_amdgcn_cvt_pk_fp8_f32(v[r][j].x * F8_H, v[r][j].y * F8_H, a, false); a = __builtin_amdgcn_cvt_pk_fp8_f32(v[r][j].z * F8_H, v[r][j].w * F8_H, a, true); h8[64 * j] = a; } } }
            if (MODE == 1) {
                float lg[R][8];
#pragma unroll
                for (int r = 0; r < R; ++r)
#pragma unroll
                    for (int e = 0; e < 8; ++e) lg[r][e] = 0.f;
#pragma unroll
                for (int j = 0; j < 4; ++j) {
#pragma unroll
                    for (int e = 0; e < 8; ++e) { const f32x4 q = rt[e * 256 + F.lane + 64 * j];
#pragma unroll
                        for (int r = 0; r < R; ++r) lg[r][e] += (v[r][j].x * q.x + v[r][j].y * q.y) + (v[r][j].z * q.z + v[r][j].w * q.w); }
                    asm volatile("" ::: "memory"); }
                static_assert(R == 4, "router reduction is written for 4 rows");
                float w[32];
#pragma unroll
                for (int r = 0; r < R; ++r)
#pragma unroll
                    for (int e = 0; e < 8; ++e) w[8 * r + e] = lg[r][e];
#pragma unroll
                for (int st = 0; st < 5; ++st) { const int half = 16 >> st, o = 1 << st; const bool hi = (F.lane & o) != 0;
#pragma unroll
                    for (int i = 0; i < half; ++i) { const float keep = hi ? w[i + half] : w[i], send = hi ? w[i] : w[i + half]; w[i] = keep + __shfl_xor(send, o); } }
                w[0] += __shfl_xor(w[0], 32);
                const bool e0 = (F.lane & 16) != 0, e1 = (F.lane & 8) != 0, e2 = (F.lane & 4) != 0;
                float ga[2], gb[4], g8[8];
                { const float rc = __shfl_xor(w[0], 16); ga[0] = e0 ? rc : w[0]; ga[1] = e0 ? w[0] : rc; }
#pragma unroll
                for (int x = 0; x < 2; ++x) { const float rc = __shfl_xor(ga[x], 8); gb[x] = e1 ? rc : ga[x]; gb[2 + x] = e1 ? ga[x] : rc; }
#pragma unroll
                for (int x = 0; x < 4; ++x) { const float rc = __shfl_xor(gb[x], 4); g8[x] = e2 ? rc : gb[x]; g8[4 + x] = e2 ? gb[x] : rc; }
                { const int r = ((F.lane & 1) << 1) | ((F.lane >> 1) & 1);
                    int i1 = 0; float v1 = g8[0];
#pragma unroll
                    for (int e = 1; e < 8; ++e) if (g8[e] > v1) { v1 = g8[e]; i1 = e; }
                    int i2 = (i1 == 0) ? 1 : 0; float v2 = -3.0e38f;
#pragma unroll
                    for (int e = 0; e < 8; ++e) if (e != i1 && g8[e] > v2) { v2 = g8[e]; i2 = e; }
                    const float w1 = 1.0f / (1.0f + expf(v2 - v1)), w2 = 1.0f - w1;
                    const int m = m0 + r, tl = tl0 + r;
                    if (F.lane < 4) { int* eid = (int*)(ws + WS_EID); float* wg = (float*)(ws + WS_WGT); eid[2 * m] = i1; eid[2 * m + 1] = i2; wg[2 * m] = w1; wg[2 * m + 1] = w2; leid[2 * tl] = i1; leid[2 * tl + 1] = i2; } }
            }
        }
        if (MODE == 1) {
            __syncthreads();
            if (F.wave == 0) {
                int cnt[8];
#pragma unroll
                for (int e = 0; e < 8; ++e) cnt[e] = 0;
                int* lrank = (int*)(ws + WS_POS) + (size_t)it * 512;
                for (int k = 0; k < 8; ++k) { const int j = 64 * k + F.lane; const int e = leid[j]; int rk = 0;
#pragma unroll
                    for (int ee = 0; ee < 8; ++ee) { const unsigned long long mask = __ballot(e == ee); const int below = __popcll(mask & ((1ull << F.lane) - 1ull)); if (e == ee) rk = cnt[ee] + below; cnt[ee] += __popcll(mask); }
                    lrank[j] = rk; }
                if (F.lane < 8) { int cv = 0;
#pragma unroll
                    for (int e = 0; e < 8; ++e) cv = (F.lane == e) ? cnt[e] : cv;
                    ((int*)(ws + WS_BCNT))[it * 8 + F.lane] = cv; }
            }
        }
    }
}

__device__ __forceinline__ void ph_gather(Frame& F) {
    unsigned char* ws = F.ws;
    const int* bcnt = (const int*)(ws + WS_BCNT); const int* eid = (const int*)(ws + WS_EID); const int* pos = (const int*)(ws + WS_POS); int* pos2 = (int*)(ws + WS_POS2);
    const bf16* H = (const bf16*)(ws + WS_H); unsigned char* HP8 = ws + WS_HP8;
    LAS int* tab = (LAS int*)(F.lds);
    constexpr int BPC = CHT / 256;
    __syncthreads();
    for (int it = blockIdx.x; it < T / 256; it += F.G) {
        const int ck = it / BPC, ib = it % BPC;
        __syncthreads();
        if (F.tid < 8) { int tot = 0, before = 0; for (int j = 0; j < BPC; ++j) { const int v = bcnt[(ck * BPC + j) * 8 + F.tid]; tot += v; if (j < ib) before += v; } tab[16 + F.tid] = tot; tab[8 + F.tid] = before; }
        __syncthreads();
        if (F.tid == 0) { int s = 0; for (int e = 0; e < 8; ++e) { tab[e] = s; s += (tab[16 + e] + 255) & ~255; }
            if (ib == 0) { int* gt = (int*)(ws + WS_TAB) + ck * 16; int ts = 0; for (int e = 0; e < 8; ++e) { gt[e] = ts; ts += (tab[16 + e] + 255) >> 8; } gt[8] = ts; } }
        __syncthreads();
        { const int j = F.tid; const int e = eid[(size_t)it * 512 + j]; const int p = ck * CH_ROWS + tab[e] + tab[8 + e] + pos[(size_t)it * 512 + j]; pos2[(size_t)it * 512 + j] = p;
          ((LAS int*)(F.lds + 1024))[j] = p; }
        __syncthreads();
        for (int k0 = 0; k0 < 64; k0 += 8) { u32x4 va[8], vb[8]; int pp[8];
#pragma unroll
            for (int k = 0; k < 8; ++k) { const int j = F.wave * 64 + k0 + k; pp[k] = ((LAS int*)(F.lds + 1024))[j]; const int m = it * 256 + (j >> 1);
                const u32x4* s = (const u32x4*)(H + (size_t)m * D); va[k] = s[F.lane]; vb[k] = s[F.lane + 64]; }
#pragma unroll
            for (int k = 0; k < 8; ++k) { u32x2* d = (u32x2*)(HP8 + (size_t)pp[k] * D); float f[8]; unsigned a, b;
                unpack8(va[k], f); a = 0; b = 0; a = __builtin_amdgcn_cvt_pk_fp8_f32(f[0] * F8_H, f[1] * F8_H, a, false); a = __builtin_amdgcn_cvt_pk_fp8_f32(f[2] * F8_H, f[3] * F8_H, a, true); b = __builtin_amdgcn_cvt_pk_fp8_f32(f[4] * F8_H, f[5] * F8_H, b, false); b = __builtin_amdgcn_cvt_pk_fp8_f32(f[6] * F8_H, f[7] * F8_H, b, true); d[F.lane] = (u32x2){a, b};
                unpack8(vb[k], f); a = 0; b = 0; a = __builtin_amdgcn_cvt_pk_fp8_f32(f[0] * F8_H, f[1] * F8_H, a, false); a = __builtin_amdgcn_cvt_pk_fp8_f32(f[2] * F8_H, f[3] * F8_H, a, true); b = __builtin_amdgcn_cvt_pk_fp8_f32(f[4] * F8_H, f[5] * F8_H, b, false); b = __builtin_amdgcn_cvt_pk_fp8_f32(f[6] * F8_H, f[7] * F8_H, b, true); d[F.lane + 64] = (u32x2){a, b}; } }
        if (ib < 8) { const int e = ib, n = tab[16 + e], r0 = ck * CH_ROWS + tab[e] + n, npad = ((n + 255) & ~255) - n;
            unsigned zz = 0u; asm volatile("" : "+v"(zz));
            for (int k = F.wave; k < npad; k += NWAVES) { u32x4* d = (u32x4*)(HP8 + (size_t)(r0 + k) * D); d[F.lane] = (u32x4){zz, zz, zz, zz}; } }
    }
}
__device__ __forceinline__ void ph_moeconv(Frame& F) {
    unsigned char* ws = F.ws; (void)ws;
    {
        __syncthreads();
        LAS float* scr = (LAS float*)(F.lds + F.wave * 16384);
        constexpr int I_13 = (D / 64) * (DFE / 32), I_2 = (DFE / 64) * (D / 32);
        constexpr int NIT = NE * (2 * I_13 + I_2);
        auto dec = [&](int it) -> TrItem { const int e = it / (2 * I_13 + I_2); const int r = it % (2 * I_13 + I_2); TrItem t;
            if (r < 2 * I_13) { const int sel = r / I_13; t = TrItem{F.in[sel == 0 ? I_M1 : I_M3] + (size_t)e * D * DFE, (bf16*)((unsigned char*)F.out + OUT_MW13 + (size_t)e * 2 * DFE * D), D, DFE, sel, r % I_13, F8_W13 * (sel == 0 ? SWG_W1 : SWG_W3)}; }
            else t = TrItem{F.in[I_M2] + (size_t)e * DFE * D, (bf16*)((unsigned char*)F.out + OUT_MW2 + (size_t)e * D * DFE), DFE, D, -1, r - 2 * I_13, F8_W2};
            return t; };
        TR_LOOP(NIT, dec)
    }
}

__device__ __forceinline__ void ph_final(Frame& F, const float* gsrc, const float* bsrc, int r_lo, int r_hi, int first_blk) {
    unsigned char* ws = F.ws;
    const bf16* H = (const bf16*)(ws + WS_H); const bf16* Y = (const bf16*)(ws + WS_Y); unsigned* pos = (unsigned*)(ws + WS_POS2); unsigned* wg = (unsigned*)(ws + WS_WGT);
    f32x4 g[4], b[4];
#pragma unroll
    for (int j = 0; j < 4; ++j) { g[j] = ((const f32x4*)gsrc)[F.lane + 64 * j]; b[j] = ((const f32x4*)bsrc)[F.lane + 64 * j]; }
    if ((int)blockIdx.x < first_blk) return;
    const int gw2 = ((int)blockIdx.x - first_blk) * NWAVES + F.wave, ngw2 = (F.G - first_blk) * NWAVES;
    for (int m0 = r_lo + gw2 * 4; m0 < r_hi; m0 += ngw2 * 4) {
        int p0[4], p1[4]; float w0[4], w1[4];
#pragma unroll
        for (int r = 0; r < 4; ++r) { const int m = m0 + r;
            p0[r] = (int)__hip_atomic_load(pos + 2 * m, __ATOMIC_RELAXED, __HIP_MEMORY_SCOPE_AGENT); p1[r] = (int)__hip_atomic_load(pos + 2 * m + 1, __ATOMIC_RELAXED, __HIP_MEMORY_SCOPE_AGENT);
            w0[r] = __uint_as_float(__hip_atomic_load(wg + 2 * m, __ATOMIC_RELAXED, __HIP_MEMORY_SCOPE_AGENT)); w1[r] = __uint_as_float(__hip_atomic_load(wg + 2 * m + 1, __ATOMIC_RELAXED, __HIP_MEMORY_SCOPE_AGENT)); }
        f32x4 v[4][4];
#pragma unroll
        for (int r = 0; r < 4; ++r) { const int m = m0 + r;
            const u32x2* hr = (const u32x2*)(H + (size_t)m * D) + F.lane; const u32x2* y0 = (const u32x2*)(Y + (size_t)p0[r] * D) + F.lane; const u32x2* y1 = (const u32x2*)(Y + (size_t)p1[r] * D) + F.lane;
#pragma unroll
            for (int j = 0; j < 4; ++j) { const u32x2 h = hr[64 * j], a = __builtin_nontemporal_load(&y0[64 * j]), c = __builtin_nontemporal_load(&y1[64 * j]);
                v[r][j].x = ALPHA * bflo(h.x) + w0[r] * bflo(a.x) + w1[r] * bflo(c.x); v[r][j].y = ALPHA * bfhi(h.x) + w0[r] * bfhi(a.x) + w1[r] * bfhi(c.x);
                v[r][j].z = ALPHA * bflo(h.y) + w0[r] * bflo(a.y) + w1[r] * bflo(c.y); v[r][j].w = ALPHA * bfhi(h.y) + w0[r] * bfhi(a.y) + w1[r] * bfhi(c.y); } }
        ln_rows<4>(v, g, b);
#pragma unroll
        for (int r = 0; r < 4; ++r) { f32x4* o = (f32x4*)(F.out + (size_t)(m0 + r) * D) + F.lane;
#pragma unroll
            for (int j = 0; j < 4; ++j) __builtin_nontemporal_store(v[r][j], &o[64 * j]); }
    }
}

constexpr int MOE_SKIP = 3;
constexpr int NPHASES = 2 + NLAYER * 6 + 3 + 2 + (NCH + 1);
__device__ __forceinline__ Frame mk_frame(const Args& args, LAS unsigned char* lds) {
    Frame F; int tid = threadIdx.x; asm volatile("" : "+v"(tid));
    size_t zo = 0; asm volatile("" : "+s"(zo));
    unsigned char* ws = args.ws + zo; float* out = (float*)((unsigned char*)args.out + zo);
    F.lds = lds; F.tid = tid; F.lane = tid & 63; F.wave = __builtin_amdgcn_readfirstlane(tid >> 6);
    F.G = gridDim.x; F.gw = blockIdx.x * NWAVES + F.wave; F.NGW = F.G * NWAVES; F.in = args.in; F.out = out; F.ws = ws;
    F.loc = (gridDim.x == 256) && !MK_PER_PHASE; F.it0 = F.loc ? 32 * (int)(blockIdx.x & 7) + (int)(blockIdx.x >> 3) : (int)blockIdx.x; return F;
}
__global__ void __launch_bounds__(NTHR, 2) mega_fwd(Args args) {
    extern __shared__ __attribute__((aligned(16))) unsigned char lds[];
    volatile LAS unsigned* MISC = (volatile LAS unsigned*)((LAS unsigned char*)lds + MISC_OFF);
    if (threadIdx.x < 32) MISC[threadIdx.x] = 0u;
    __syncthreads();
    XcdBarrier bar; bar.bar = (unsigned*)(args.ws + WS_CTL) + CW_BAR; bar.x = 0; bar.st = nullptr;
    if (!MK_PER_PHASE) bar = xcd_barrier_post((unsigned*)(args.ws + WS_CTL) + CW_BAR, MISC + 8);
    const int lo = args.ph_lo, hi = args.ph_hi;
    int pc = 0; unsigned ggen = 0u;
#define PH_BEGIN if (pc >= lo && pc < hi) { Frame F = mk_frame(args, (LAS unsigned char*)lds); unsigned char* ws = F.ws; PG8_LAS unsigned char* glds = (PG8_LAS unsigned char*)F.lds; bf16* H = (bf16*)(ws + WS_H); (void)glds; (void)H;
#define PH_END   if (pc + 1 < hi) xcd_barrier(bar); } ++pc;
#define PH_END_L if (pc + 1 < hi) { if (F.loc) grp_barrier(bar.bar, blockIdx.x & 7u, gridDim.x >> 3, ggen); else xcd_barrier(bar); } } ++pc;

    PH_BEGIN ph_prologue_a(F); PH_END
    PH_BEGIN ph_prologue_b(F); PH_END
    for (int l = 0; l < NLAYER; ++l) {
        PH_BEGIN { pg8::Gemm g{H, (const bf16*)(ws + WS_WINT) + (size_t)l * PROJ * D, T, PROJ, D}; pg8::StaticOrder S; S.init(T, PROJ, F.G, (int)blockIdx.x);
                   pg8::EpiProj E{(bf16*)F.out, (bf16*)(ws + WS_S3), (bf16*)(ws + WS_S4), (bf16*)(ws + WS_S5), (bf16*)(ws + WS_S6), (bf16*)(ws + WS_SB),
                                  F.in[I_CAW] + (size_t)l * 3 * D, F.in[I_CHW] + (size_t)l * 3 * 3 * D, F.in[I_CHB] + (size_t)l * 3 * D};
                   pg8::gemm_phase<pg8::EpiProj, pg8::StaticOrder, false, true>(glds, g, S, E);
                   } PH_END_L
        PH_BEGIN ph_fix(F, l); PH_END
        PH_BEGIN ph_conv(F, l); PH_END
        PH_BEGIN { pg8::Gemm g{(const bf16*)F.out, (const bf16*)(ws + WS_WAT) + (size_t)l * D * D, T, D, 2 * D, 0, 0, (const bf16*)F.out + (size_t)T * D, (const bf16*)(ws + WS_WHT) + (size_t)l * D * D}; pg8::StaticOrder S; S.init(T, D, F.G, (int)blockIdx.x);
                   pg8::EpiMerge2 E{(const bf16*)(ws + WS_S5), (const bf16*)(ws + WS_S6), (bf16*)(ws + WS_S5), D}; pg8::gemm_phase<pg8::EpiMerge2, pg8::StaticOrder, true, true, false, true, true>(glds, g, S, E); } PH_END_L
        PH_BEGIN { pg8::Gemm g{(const bf16*)(ws + WS_S5), (const bf16*)(ws + WS_WOT) + (size_t)l * D * D, T, D, D}; pg8::StaticOrder S; S.init(T, D, F.G, (int)blockIdx.x, 1);
                   pg8::EpiResBf16 E{(bf16*)F.out, H, D, ALPHA}; pg8::gemm_phase<pg8::EpiResBf16, pg8::StaticOrder, true, true>(glds, g, S, E); } PH_END_L
        if (l == 0) {
            PH_BEGIN ph_ln<2>(F, F.in[I_LNMG], F.in[I_LNMB]); PH_END_L
            PH_BEGIN { pg8::Gemm g{(const bf16*)(ws + WS_H8F), (const bf16*)(ws + WS_W13), T, 2 * DFF, D, E8_H, E8_W13}; pg8::StaticOrder S; S.init(T, 2 * DFF, F.G, (int)blockIdx.x);
                       pg8::EpiSwiglu8 E{ws + WS_ACT0, DFF, 0, F8_ACT}; pg8::gemm_phase<pg8::EpiSwiglu8, pg8::StaticOrder, true, true, true>(glds, g, S, E); } PH_END_L
            PH_BEGIN { pg8::Gemm g{(const bf16*)(ws + WS_ACT0), (const bf16*)(ws + WS_W2), T, D, DFF, E8_ACT, E8_W2}; pg8::StaticOrder S; S.init(T, D, F.G, (int)blockIdx.x, 1);
                       pg8::EpiResBf16 E{(bf16*)F.out, H, D, ALPHA}; pg8::gemm_phase<pg8::EpiResBf16, pg8::StaticOrder, true, true, true>(glds, g, S, E); } PH_END_L
            PH_BEGIN ph_ln<0>(F, F.in[I_LNFG], F.in[I_LNFB]); PH_END_L
        } else {
            PH_BEGIN ph_ln<1>(F, F.in[I_LNMG] + D, F.in[I_LNMB] + D); PH_END
            PH_BEGIN { ph_gather(F); ph_moeconv(F); } PH_END
            for (int ck = 0; ck <= NCH; ++ck) {
                PH_BEGIN {
                    int nheavy = 0;
                    if (ck > 0) { const int cd = ck - 1;
                        pg8::Gemm g{(const bf16*)(ws + WS_ACT8 + (size_t)(cd & 1) * ACT8_BYTES), (const bf16*)((unsigned char*)F.out + OUT_MW2), 0, 0, DFE, E8_ACT, E8_W2}; pg8::MoeOrder S; S.initm((const int*)(ws + WS_TAB) + cd * 16, D / 256, F.G, (int)blockIdx.x, 0, 0, 1);
                        nheavy = S.nwg % F.G;
                        pg8::EpiPlain E{(bf16*)(ws + WS_Y) + (size_t)cd * CH_ROWS * D, D, D / 256}; pg8::gemm_phase<pg8::EpiPlain, pg8::MoeOrder, true, true, true>(glds, g, S, E); }
                    __syncthreads();
                    if (ck < NCH) {
                        pg8::Gemm g{(const bf16*)(ws + WS_HP8 + (size_t)ck * CH_ROWS * D), (const bf16*)((unsigned char*)F.out + OUT_MW13), 0, 0, D, E8_H, E8_W13}; pg8::MoeOrder S; S.initm((const int*)(ws + WS_TAB) + ck * 16, 2 * DFE / 256, F.G, (int)blockIdx.x, nheavy, nheavy ? MOE_SKIP : 0);
                        pg8::EpiSwiglu8 E{ws + WS_ACT8 + (size_t)(ck & 1) * ACT8_BYTES, DFE, 2 * DFE / 256, F8_ACT}; pg8::gemm_phase<pg8::EpiSwiglu8, pg8::MoeOrder, true, true, true>(glds, g, S, E); }
                    if (ck == NCH) ph_final(F, F.in[I_LNFG] + D, F.in[I_LNFB] + D, 0, (NCH - 1) * CHT, nheavy);
                } PH_END
            }
            PH_BEGIN ph_final(F, F.in[I_LNFG] + D, F.in[I_LNFB] + D, (NCH - 1) * CHT, T, 0); PH_END
        }
    }
#undef PH_BEGIN
#undef PH_END
#undef PH_END_L
}

extern "C" void kernel_launch(void* const* d_in, const int* in_sizes, int n_in, void* d_out, int out_size, void* d_ws, size_t ws_size, hipStream_t stream) {
    static int grid = 0;
    if (grid == 0) {
        if (n_in != 28 || out_size != T * D || ws_size < WS_END) { fprintf(stderr, "kernel_launch: unexpected shapes (n_in %d, out %d, ws %zu)\n", n_in, out_size, ws_size); grid = -1; return; }
        int dev = 0, cus = 0, per_cu = 0;
        if (hipGetDevice(&dev) != hipSuccess || hipDeviceGetAttribute(&cus, hipDeviceAttributeMultiprocessorCount, dev) != hipSuccess) { grid = -1; return; }
        if (hipFuncSetAttribute((const void*)mega_fwd, hipFuncAttributeMaxDynamicSharedMemorySize, LDS_BYTES) != hipSuccess) { fprintf(stderr, "kernel_launch: hipFuncSetAttribute failed\n"); grid = -1; return; }
        if (hipOccupancyMaxActiveBlocksPerMultiprocessor(&per_cu, (const void*)mega_fwd, NTHR, LDS_BYTES) != hipSuccess || per_cu < 1) fprintf(stderr, "kernel_launch: occupancy query reports %d\n", per_cu);
        (void)hipGetLastError();
        grid = cus;
    }
    if (grid < 0) return;
    (void)hipMemsetAsync((char*)d_ws + WS_CTL, 0, CTL_ZERO_BYTES, stream);
    Args a{};
    for (int i = 0; i < 28; ++i) a.in[i] = (const float*)d_in[i];
    a.out = (float*)d_out; a.ws = (unsigned char*)d_ws;
#if MK_PER_PHASE
    for (int p = 0; p < NPHASES; ++p) { a.ph_lo = p; a.ph_hi = p + 1; hipLaunchKernelGGL(mega_fwd, dim3(grid), dim3(NTHR), LDS_BYTES, stream, a); }
#else
    a.ph_lo = 0; a.ph_hi = NPHASES;
    hipLaunchKernelGGL(mega_fwd, dim3(grid), dim3(NTHR), LDS_BYTES, stream, a);
#endif
}
```

```cpp
#include <hip/hip_runtime.h>
#include <cstdio>
#include <cstdint>

#ifndef MK_PER_PHASE
#define MK_PER_PHASE 0
#endif

namespace pg8 {
#define PG8_LAS __attribute__((address_space(3)))
typedef unsigned short bf16_t;
typedef short bf16x8 __attribute__((ext_vector_type(8)));
typedef short s16x4 __attribute__((ext_vector_type(4)));
typedef float f32x4 __attribute__((ext_vector_type(4)));
typedef unsigned u32x4 __attribute__((ext_vector_type(4)));
typedef int i32x4 __attribute__((ext_vector_type(4)));
typedef int i32x8 __attribute__((ext_vector_type(8)));
constexpr int BM = 256, BK = 64, HALF = 128, HTB = HALF * BK * 2  , STAGE_BYTES = 8 * HTB, NXCD = 8, WGM = 8;

__host__ __device__ __forceinline__ int lds_byte(int r, int c) { const int st = (r >> 4) * 2 + (c >> 5), rr = r & 15, cc = c & 31, ob = rr * 64 + cc * 2; return st * 1024 + (ob ^ (((ob >> 9) & 1) << 5)); }
__host__ __device__ __forceinline__ void stage_rc(int b, int& R, int& C) { const int st = b / 1024, sb = b % 1024, swz = sb ^ (((sb >> 9) & 1) << 5); R = (st >> 1) * 16 + swz / 64; C = (st & 1) * 32 + (swz % 64) / 2; }
__host__ __device__ __forceinline__ int perm32(int rho) { const int n = rho >> 4, i = rho & 15; return 8 * (i >> 2) + 4 * n + (i & 3); }

struct Unit { int pm, pn; };
struct Gemm { const bf16_t* A; const bf16_t* Bt; int M, N, K; int sa = 0, sb = 0; const bf16_t* A2 = nullptr; const bf16_t* B2t = nullptr; };

struct StaticOrder {
    int nM, nN, nwg, G, c, rev;
    __host__ __device__ void init(int M, int N, int G_, int c_, int rev_ = 0) { nM = M / BM; nN = N / BM; nwg = nM * nN; G = G_; c = c_; rev = (rev_ && nwg % G_ == 0) ? 1 : 0; }
    __host__ __device__ bool next(int i, Unit& u) const {
        const long L = (long)(rev ? (nwg / G - 1 - i) : i) * G + c; if (i < 0 || L < 0 || L >= nwg) return false;
        int wgid = (int)L; { const int q = nwg / NXCD, r = nwg % NXCD, xcd = wgid % NXCD, off = wgid / NXCD; wgid = (xcd < r ? xcd * (q + 1) : r * (q + 1) + (xcd - r) * q) + off; }
        const int nig = WGM * nN, gid = wgid / nig, fm = gid * WGM, gsz = (nM - fm) < WGM ? (nM - fm) : WGM;
        u.pm = fm + ((wgid % nig) % gsz); u.pn = (wgid % nig) / gsz; return true;
    }
    __device__ __forceinline__ void a_ready(const Unit&) const {}
    __device__ __forceinline__ void done(const Unit&) const {}
};

struct MoeOrder : StaticOrder {
    int ts[9], NT, nh, skip;
    __device__ void initm(const int* tab, int NT_, int G_, int c_, int nh_, int skip_, int rev_ = 0) {
#pragma unroll
        for (int e = 0; e < 9; ++e) ts[e] = __builtin_amdgcn_readfirstlane((int)__hip_atomic_load((unsigned*)tab + e, __ATOMIC_RELAXED, __HIP_MEMORY_SCOPE_AGENT));
        NT = NT_; nM = ts[8]; nN = NT_; nwg = nM * nN; G = G_; c = c_; nh = nh_; skip = skip_; rev = (rev_ && nh_ == 0 && skip_ == 0) ? 1 : 0; }
    __device__ bool next(int i, Unit& u) const {
        long L;
        if (rev) { const int nrc = (nwg - c + G - 1) / G; if (i >= nrc) return false; L = (long)(nrc - 1 - i) * G + c; }
        else if (c < nh) L = (long)skip * (G - nh) + (long)i * G + c;
        else if (i < skip) L = (long)i * (G - nh) + (c - nh);
        else L = (long)skip * (G - nh) + (long)(i - skip) * G + c;
        if (L >= nwg) return false;
        int wgid = (int)L; { const int q = nwg / NXCD, r = nwg % NXCD, xcd = wgid % NXCD, off = wgid / NXCD; wgid = (xcd < r ? xcd * (q + 1) : r * (q + 1) + (xcd - r) * q) + off; }
        const int nig = WGM * nN, gid = wgid / nig, fm = gid * WGM, gsz = (nM - fm) < WGM ? (nM - fm) : WGM;
        u.pm = fm + ((wgid % nig) % gsz); u.pn = (wgid % nig) / gsz;
        int e = 0;
#pragma unroll
        for (int k = 1; k < 8; ++k) e += (u.pm >= ts[k]) ? 1 : 0;
        u.pn += e * NT; return true; }
};

__device__ __forceinline__ unsigned cvt_pk_bf16(float lo, float hi) { unsigned r; asm volatile("v_cvt_pk_bf16_f32 %0, %1, %2" : "=v"(r) : "v"(lo), "v"(hi)); return r; }
__device__ __forceinline__ float bflo(unsigned w) { return __uint_as_float(w << 16); }
__device__ __forceinline__ float bfhi(unsigned w) { return __uint_as_float(w & 0xffff0000u); }
__device__ __forceinline__ u32x4 pack8(const f32x4 v0, const f32x4 v1) { u32x4 w; w.x = cvt_pk_bf16(v0[0], v0[1]); w.y = cvt_pk_bf16(v0[2], v0[3]); w.z = cvt_pk_bf16(v1[0], v1[1]); w.w = cvt_pk_bf16(v1[2], v1[3]); return w; }
__device__ __forceinline__ void mul8(f32x4& v0, f32x4& v1, const u32x4 g) { v0[0] *= bflo(g.x); v0[1] *= bfhi(g.x); v0[2] *= bflo(g.y); v0[3] *= bfhi(g.y); v1[0] *= bflo(g.z); v1[1] *= bfhi(g.z); v1[2] *= bflo(g.w); v1[3] *= bfhi(g.w); }
__device__ __forceinline__ float silu_f(float x) { return x * __builtin_amdgcn_rcpf(1.0f + __builtin_amdgcn_exp2f(-1.44269504f * x)); }

struct EpiPlain {
    static constexpr bool PERM = true, AFTER_DRAIN = false;
    bf16_t* O; int ldc; int ncolt;
    __device__ __forceinline__ void operator()(const f32x4 (&acc)[2][2][4][2], const Unit& u, int wr, int wc, int fr, int fq) const {
        const int row0 = u.pm * BM + wr * 64 + fr; const int tn = ncolt ? (u.pn % ncolt) : u.pn; const int col0 = tn * BM + wc * 32 + 8 * fq;
#pragma unroll
        for (int ai = 0; ai < 2; ++ai)
#pragma unroll
            for (int m = 0; m < 4; ++m) { bf16_t* rowp = O + (size_t)(row0 + ai * HALF + m * 16) * ldc + col0;
#pragma unroll
                for (int bj = 0; bj < 2; ++bj) *(u32x4*)(rowp + bj * HALF) = pack8(acc[ai][bj][m][0], acc[ai][bj][m][1]); }
    }
};
struct EpiMulGate {
    static constexpr bool PERM = true, AFTER_DRAIN = false;
    const bf16_t* G; bf16_t* O; int ldc;
    __device__ __forceinline__ void operator()(const f32x4 (&acc)[2][2][4][2], const Unit& u, int wr, int wc, int fr, int fq) const {
        const int row0 = u.pm * BM + wr * 64 + fr; const int col0 = u.pn * BM + wc * 32 + 8 * fq;
#pragma unroll
        for (int ai = 0; ai < 2; ++ai)
#pragma unroll
            for (int m = 0; m < 4; ++m) { const size_t off = (size_t)(row0 + ai * HALF + m * 16) * ldc + col0;
#pragma unroll
                for (int bj = 0; bj < 2; ++bj) { f32x4 v0 = acc[ai][bj][m][0], v1 = acc[ai][bj][m][1]; const u32x4 g = *(const u32x4*)(G + off + bj * HALF); mul8(v0, v1, g); *(u32x4*)(O + off + bj * HALF) = pack8(v0, v1); } }
    }
};
struct EpiMerge {
    static constexpr bool PERM = true, AFTER_DRAIN = false;
    const bf16_t* G; const bf16_t* M1; bf16_t* O; int ldc;
    __device__ __forceinline__ void operator()(const f32x4 (&acc)[2][2][4][2], const Unit& u, int wr, int wc, int fr, int fq) const {
        const int row0 = u.pm * BM + wr * 64 + fr; const int col0 = u.pn * BM + wc * 32 + 8 * fq;
#pragma unroll
        for (int ai = 0; ai < 2; ++ai)
#pragma unroll
            for (int m = 0; m < 4; ++m) { const size_t off = (size_t)(row0 + ai * HALF + m * 16) * ldc + col0;
#pragma unroll
                for (int bj = 0; bj < 2; ++bj) { f32x4 v0 = acc[ai][bj][m][0], v1 = acc[ai][bj][m][1]; const u32x4 g = *(const u32x4*)(G + off + bj * HALF); const u32x4 q = *(const u32x4*)(M1 + off + bj * HALF); mul8(v0, v1, g);
                    v0[0] += bflo(q.x); v0[1] += bfhi(q.x); v0[2] += bflo(q.y); v0[3] += bfhi(q.y); v1[0] += bflo(q.z); v1[1] += bfhi(q.z); v1[2] += bflo(q.w); v1[3] += bfhi(q.w);
                    *(u32x4*)(O + off + bj * HALF) = pack8(v0, v1); } }
    }
};
struct EpiMerge2 {
    static constexpr bool PERM = true, AFTER_DRAIN = false;
    const bf16_t* R; const bf16_t* G; bf16_t* O; int ldc;
    __device__ __forceinline__ void mid(f32x4 (&acc)[2][2][4][2], const Unit& u, int wr, int wc, int fr, int fq) const {
        asm volatile("" : "+v"(fr));
        const int row0 = u.pm * BM + wr * 64 + fr; const int col0 = u.pn * BM + wc * 32 + 8 * fq;
#pragma unroll
        for (int ai = 0; ai < 2; ++ai)
#pragma unroll
            for (int m = 0; m < 4; ++m) { const size_t off = (size_t)(row0 + ai * HALF + m * 16) * ldc + col0;
#pragma unroll
                for (int bj = 0; bj < 2; ++bj) { const u32x4 r = *(const u32x4*)(R + off + bj * HALF); mul8(acc[ai][bj][m][0], acc[ai][bj][m][1], r); }
                }
    }
    __device__ __forceinline__ void operator()(const f32x4 (&acc)[2][2][4][2], const Unit& u, int wr, int wc, int fr, int fq) const {
        const int row0 = u.pm * BM + wr * 64 + fr; const int col0 = u.pn * BM + wc * 32 + 8 * fq;
#pragma unroll
        for (int ai = 0; ai < 2; ++ai)
#pragma unroll
            for (int m = 0; m < 4; ++m) { const size_t off = (size_t)(row0 + ai * HALF + m * 16) * ldc + col0;
#pragma unroll
                for (int bj = 0; bj < 2; ++bj) { f32x4 v0 = acc[ai][bj][m][0], v1 = acc[ai][bj][m][1]; const u32x4 g = *(const u32x4*)(G + off + bj * HALF); mul8(v0, v1, g); *(u32x4*)(O + off + bj * HALF) = pack8(v0, v1); } }
    }
};
struct EpiSwiglu {
    static constexpr bool PERM = true, AFTER_DRAIN = false;
    bf16_t* O; int ldo; int ncolt;
    __device__ __forceinline__ void operator()(const f32x4 (&acc)[2][2][4][2], const Unit& u, int wr, int wc, int fr, int fq) const {
        const int row0 = u.pm * BM + wr * 64 + fr; const int tn = ncolt ? (u.pn % ncolt) : u.pn; const int col0 = tn * HALF + wc * 32 + 8 * fq;
#pragma unroll
        for (int ai = 0; ai < 2; ++ai)
#pragma unroll
            for (int m = 0; m < 4; ++m) { f32x4 v0, v1;
#pragma unroll
                for (int j = 0; j < 4; ++j) { v0[j] = silu_f(acc[ai][0][m][0][j]) * acc[ai][1][m][0][j]; v1[j] = silu_f(acc[ai][0][m][1][j]) * acc[ai][1][m][1][j]; }
                *(u32x4*)(O + (size_t)(row0 + ai * HALF + m * 16) * ldo + col0) = pack8(v0, v1); }
    }
};
struct EpiResF32 {
    static constexpr bool PERM = false, AFTER_DRAIN = false;
    float* C; const bf16_t* R; int ldc; float alpha;
    __device__ __forceinline__ void operator()(const f32x4 (&acc)[2][2][4][2], const Unit& u, int wr, int wc, int fr, int fq) const {
        const int row0 = u.pm * BM + wr * 64 + fr, col0 = u.pn * BM + wc * 32 + 4 * fq;
        typedef unsigned u32x2v __attribute__((ext_vector_type(2)));
#pragma unroll
        for (int ai = 0; ai < 2; ++ai)
#pragma unroll
            for (int m = 0; m < 4; ++m) { const size_t off = (size_t)(row0 + ai * HALF + m * 16) * ldc + col0;
#pragma unroll
                for (int bj = 0; bj < 2; ++bj)
#pragma unroll
                    for (int n = 0; n < 2; ++n) { const u32x2v h = *(const u32x2v*)(R + off + bj * HALF + n * 16); f32x4 o = acc[ai][bj][m][n];
                        o[0] += alpha * bflo(h.x); o[1] += alpha * bfhi(h.x); o[2] += alpha * bflo(h.y); o[3] += alpha * bfhi(h.y);
                        *(f32x4*)(C + off + bj * HALF + n * 16) = o; } }
    }
};


__device__ __forceinline__ float dpp_ror1(float x) { return __int_as_float(__builtin_amdgcn_update_dpp(0, __float_as_int(x), 0x121, 0xF, 0xF, false)); }
__device__ __forceinline__ float dpp_ror15(float x) { return __int_as_float(__builtin_amdgcn_update_dpp(0, __float_as_int(x), 0x12F, 0xF, 0xF, false)); }
struct EpiProj {
    static constexpr bool PERM = false, AFTER_DRAIN = false;
    static constexpr size_t SBN = (size_t)2048 * 1024;
    bf16_t *YA, *X0T, *ZT, *GA, *GH, *SB; const float *caw, *chw, *chb;
    __device__ __forceinline__ void operator()(const f32x4 (&acc)[2][2][4][2], const Unit& u, int wr, int wc, int fr, int fq) const {
        typedef unsigned u32x2v __attribute__((ext_vector_type(2)));
        const int type = u.pn >> 4, q = u.pn & 15, ch0 = 64 * q + 16 * wc + 4 * fq;
        const int row0 = u.pm * BM + wr * 64 + fr, b = row0 >> 12, p0 = row0 & 4095;
        const size_t cmaj = ((size_t)ch0 * 16 + b) * 4096 + p0;
        const bool top = fr == 0, bot = fr == 15;
        if (type == 0) {
            const f32x4 w0 = *(const f32x4*)(caw + ch0), w1 = *(const f32x4*)(caw + 1024 + ch0), w2 = *(const f32x4*)(caw + 2048 + ch0);
#pragma unroll
            for (int ai = 0; ai < 2; ++ai) {
                f32x4 cu[4];
#pragma unroll
                for (int m = 0; m < 4; ++m)
#pragma unroll
                    for (int j = 0; j < 4; ++j) cu[m][j] = acc[ai][0][m][1][j] * acc[ai][1][m][0][j];
#pragma unroll
                for (int m = 0; m < 4; ++m) { const int dr = ai * HALF + m * 16; const size_t tm = (size_t)(row0 + dr) * 1024 + ch0;
                    const f32x4 ab = acc[ai][0][m][0], x0 = acc[ai][1][m][1]; f32x4 y;
#pragma unroll
                    for (int j = 0; j < 4; ++j) { const float tp = bot ? (m > 0 ? cu[m > 0 ? m - 1 : 0][j] : 0.f) : cu[m][j], tn = top ? (m < 3 ? cu[m < 3 ? m + 1 : 3][j] : 0.f) : cu[m][j];
                        y[j] = ab[j] * (w0[j] * dpp_ror1(tp) + w1[j] * cu[m][j] + w2[j] * dpp_ror15(tn)); }
                    u32x2v w; w.x = cvt_pk_bf16(y[0], y[1]); w.y = cvt_pk_bf16(y[2], y[3]); *(u32x2v*)(YA + tm) = w;
                    const unsigned x01 = cvt_pk_bf16(x0[0], x0[1]), x23 = cvt_pk_bf16(x0[2], x0[3]);
                    X0T[cmaj + dr] = (bf16_t)(x01 & 0xffffu); X0T[cmaj + 65536 + dr] = (bf16_t)(x01 >> 16); X0T[cmaj + 2 * 65536 + dr] = (bf16_t)(x23 & 0xffffu); X0T[cmaj + 3 * 65536 + dr] = (bf16_t)(x23 >> 16);
                    if ((m == 0 && top) || (m == 3 && bot)) { const size_t so = (size_t)(((row0 + dr) >> 6) * 2 + (m == 3 ? 1 : 0)) * 1024 + ch0;
                        w.x = cvt_pk_bf16(ab[0], ab[1]); w.y = cvt_pk_bf16(ab[2], ab[3]); *(u32x2v*)(SB + so) = w;
                        w.x = cvt_pk_bf16(cu[m][0], cu[m][1]); w.y = cvt_pk_bf16(cu[m][2], cu[m][3]); *(u32x2v*)(SB + SBN + so) = w; } }
            }
        } else {
#pragma unroll
            for (int bj = 0; bj < 2; ++bj) {
                const int ch1 = 64 * (2 * (u.pn & 7) + bj) + 16 * wc + 4 * fq; const size_t cmaj1 = ((size_t)ch1 * 16 + b) * 4096 + p0;
                const f32x4 wv0 = *(const f32x4*)(chw + ch1), wv1 = *(const f32x4*)(chw + 3 * 1024 + ch1), wv2 = *(const f32x4*)(chw + 6 * 1024 + ch1), bv = *(const f32x4*)(chb + ch1);
                const f32x4 wx0 = *(const f32x4*)(chw + 1024 + ch1), wx1 = *(const f32x4*)(chw + 4 * 1024 + ch1), wx2 = *(const f32x4*)(chw + 7 * 1024 + ch1), bx = *(const f32x4*)(chb + 1024 + ch1);
#pragma unroll
                for (int ai = 0; ai < 2; ++ai)
#pragma unroll
                    for (int m = 0; m < 4; ++m) { const int dr = ai * HALF + m * 16;
                        const f32x4 v = acc[ai][bj][m][0], x1 = acc[ai][bj][m][1]; f32x4 pv, px, z;
#pragma unroll
                        for (int j = 0; j < 4; ++j) {
                            const float vp = bot ? (m > 0 ? acc[ai][bj][m > 0 ? m - 1 : 0][0][j] : 0.f) : v[j], vn = top ? (m < 3 ? acc[ai][bj][m < 3 ? m + 1 : 3][0][j] : 0.f) : v[j];
                            const float xp = bot ? (m > 0 ? acc[ai][bj][m > 0 ? m - 1 : 0][1][j] : 0.f) : x1[j], xn = top ? (m < 3 ? acc[ai][bj][m < 3 ? m + 1 : 3][1][j] : 0.f) : x1[j];
                            pv[j] = bv[j] + wv0[j] * dpp_ror1(vp) + wv1[j] * v[j] + wv2[j] * dpp_ror15(vn); px[j] = bx[j] + wx0[j] * dpp_ror1(xp) + wx1[j] * x1[j] + wx2[j] * dpp_ror15(xn); z[j] = pv[j] * px[j]; }
                        const unsigned z01 = cvt_pk_bf16(z[0], z[1]), z23 = cvt_pk_bf16(z[2], z[3]);
                        ZT[cmaj1 + dr] = (bf16_t)(z01 & 0xffffu); ZT[cmaj1 + 65536 + dr] = (bf16_t)(z01 >> 16); ZT[cmaj1 + 2 * 65536 + dr] = (bf16_t)(z23 & 0xffffu); ZT[cmaj1 + 3 * 65536 + dr] = (bf16_t)(z23 >> 16);
                        u32x2v w;
                        if ((m == 0 && top) || (m == 3 && bot)) { const size_t so = (size_t)(((row0 + dr) >> 6) * 2 + (m == 3 ? 1 : 0)) * 1024 + ch1;
                            w.x = cvt_pk_bf16(pv[0], pv[1]); w.y = cvt_pk_bf16(pv[2], pv[3]); *(u32x2v*)(SB + 2 * SBN + so) = w;
                            w.x = cvt_pk_bf16(px[0], px[1]); w.y = cvt_pk_bf16(px[2], px[3]); *(u32x2v*)(SB + 3 * SBN + so) = w;
                            w.x = cvt_pk_bf16(v[0], v[1]); w.y = cvt_pk_bf16(v[2], v[3]); *(u32x2v*)(SB + 4 * SBN + so) = w;
                            w.x = cvt_pk_bf16(x1[0], x1[1]); w.y = cvt_pk_bf16(x1[2], x1[3]); *(u32x2v*)(SB + 5 * SBN + so) = w; } }
            }
        }
    }
};

struct EpiGate8 {
    static constexpr bool PERM = false, AFTER_DRAIN = false;
    bf16_t *GA, *GH;
    __device__ __forceinline__ void operator()(const f32x4 (&acc)[2][2][4][2], const Unit& u, int wr, int wc, int fr, int fq) const {
        typedef unsigned u32x2v __attribute__((ext_vector_type(2)));
        const int row0 = u.pm * BM + wr * 64 + fr;
#pragma unroll
        for (int bj = 0; bj < 2; ++bj) { const int ch1 = 64 * (2 * u.pn + bj) + 16 * wc + 4 * fq;
#pragma unroll
            for (int ai = 0; ai < 2; ++ai)
#pragma unroll
                for (int m = 0; m < 4; ++m) { const size_t tm = (size_t)(row0 + ai * HALF + m * 16) * 1024 + ch1; f32x4 ga = acc[ai][bj][m][0], gh = acc[ai][bj][m][1]; u32x2v w;
#pragma unroll
                    for (int j = 0; j < 4; ++j) { const float ea = 1.0f + __builtin_amdgcn_exp2f(ga[j]), eh = 1.0f + __builtin_amdgcn_exp2f(__builtin_fminf(gh[j], 64.0f));
                        ga[j] = eh * __builtin_amdgcn_rcpf(ea); gh[j] = __builtin_amdgcn_rcpf(eh); }
                    w.x = cvt_pk_bf16(ga[0], ga[1]); w.y = cvt_pk_bf16(ga[2], ga[3]); *(u32x2v*)(GA + tm) = w;
                    w.x = cvt_pk_bf16(gh[0], gh[1]); w.y = cvt_pk_bf16(gh[2], gh[3]); *(u32x2v*)(GH + tm) = w; } }
    }
};

struct EpiResBf16 {
    static constexpr bool PERM = true, AFTER_DRAIN = false;
    bf16_t* O; const bf16_t* R; int ldc; float alpha;
    __device__ __forceinline__ void operator()(const f32x4 (&acc)[2][2][4][2], const Unit& u, int wr, int wc, int fr, int fq) const {
        const int row0 = u.pm * BM + wr * 64 + fr; const int col0 = u.pn * BM + wc * 32 + 8 * fq;
#pragma unroll
        for (int ai = 0; ai < 2; ++ai)
#pragma unroll
            for (int m = 0; m < 4; ++m) { const size_t off = (size_t)(row0 + ai * HALF + m * 16) * ldc + col0;
#pragma unroll
                for (int bj = 0; bj < 2; ++bj) { f32x4 v0 = acc[ai][bj][m][0], v1 = acc[ai][bj][m][1]; const u32x4 q = *(const u32x4*)(R + off + bj * HALF);
                    v0[0] += alpha * bflo(q.x); v0[1] += alpha * bfhi(q.x); v0[2] += alpha * bflo(q.y); v0[3] += alpha * bfhi(q.y); v1[0] += alpha * bflo(q.z); v1[1] += alpha * bfhi(q.z); v1[2] += alpha * bflo(q.w); v1[3] += alpha * bfhi(q.w);
                    *(u32x4*)(O + off + bj * HALF) = pack8(v0, v1); } }
    }
};

__device__ __forceinline__ float clamp8(float x) { return __builtin_fminf(__builtin_fmaxf(x, -416.f), 416.f); }
typedef unsigned u32x2p __attribute__((ext_vector_type(2)));
__device__ __forceinline__ u32x2p pack8_fp8(const f32x4 v0, const f32x4 v1, float s) { u32x2p w; unsigned a = 0, b = 0;
    a = __builtin_amdgcn_cvt_pk_fp8_f32(clamp8(v0[0] * s), clamp8(v0[1] * s), a, false); a = __builtin_amdgcn_cvt_pk_fp8_f32(clamp8(v0[2] * s), clamp8(v0[3] * s), a, true);
    b = __builtin_amdgcn_cvt_pk_fp8_f32(clamp8(v1[0] * s), clamp8(v1[1] * s), b, false); b = __builtin_amdgcn_cvt_pk_fp8_f32(clamp8(v1[2] * s), clamp8(v1[3] * s), b, true);
    w.x = a; w.y = b; return w; }
__device__ __forceinline__ u32x2p pack8_fp8_ns(const f32x4 v0, const f32x4 v1) { u32x2p w; unsigned a = 0, b = 0;
    a = __builtin_amdgcn_cvt_pk_fp8_f32(clamp8(v0[0]), clamp8(v0[1]), a, false); a = __builtin_amdgcn_cvt_pk_fp8_f32(clamp8(v0[2]), clamp8(v0[3]), a, true);
    b = __builtin_amdgcn_cvt_pk_fp8_f32(clamp8(v1[0]), clamp8(v1[1]), b, false); b = __builtin_amdgcn_cvt_pk_fp8_f32(clamp8(v1[2]), clamp8(v1[3]), b, true);
    w.x = a; w.y = b; return w; }
struct EpiSwiglu8 {
    static constexpr bool PERM = true, AFTER_DRAIN = false;
    unsigned char* O; int ldo; int ncolt; float scale;
    __device__ __forceinline__ void operator()(const f32x4 (&acc)[2][2][4][2], const Unit& u, int wr, int wc, int fr, int fq) const {
        const int row0 = u.pm * BM + wr * 64 + fr; const int tn = ncolt ? (u.pn % ncolt) : u.pn; const int col0 = tn * HALF + wc * 32 + 8 * fq;
#pragma unroll
        for (int ai = 0; ai < 2; ++ai)
#pragma unroll
            for (int m = 0; m < 4; ++m) { f32x4 v0, v1;
#pragma unroll
                for (int j = 0; j < 4; ++j) { const float g0 = acc[ai][0][m][0][j], g1 = acc[ai][0][m][1][j];
                    v0[j] = g0 * __builtin_amdgcn_rcpf(1.0f + __builtin_amdgcn_exp2f(g0)) * acc[ai][1][m][0][j]; v1[j] = g1 * __builtin_amdgcn_rcpf(1.0f + __builtin_amdgcn_exp2f(g1)) * acc[ai][1][m][1][j]; }
                *(u32x2p*)(O + (size_t)(row0 + ai * HALF + m * 16) * ldo + col0) = pack8_fp8_ns(v0, v1); }
    }
};
template <class Epi, class Sched, bool ALIGN_EPI = false, bool SP2 = false, bool F8 = false, bool SPLIT2 = false, bool A2T = false>
__device__ __forceinline__ void gemm_phase(PG8_LAS unsigned char* lds, const Gemm g, const Sched& S, const Epi& E) {
    int tid_ = threadIdx.x; asm volatile("" : "+v"(tid_)); const int tid = tid_, wid = __builtin_amdgcn_readfirstlane(tid >> 6), lane = tid & 63, wr = wid >> 2, wc = wid & 3, fr = lane & 15, fq = lane >> 4;
    const int K = SPLIT2 ? g.K / 2 : g.K, nt = F8 ? g.K / (2 * BK) : g.K / BK, nh = nt / 2; (void)nh;
    const int esz = F8 ? 1 : 2; const int sa_ = g.sa, sb_ = g.sb; (void)sa_; (void)sb_;
    unsigned voffA[2], voffB[2];
#pragma unroll
    for (int i = 0; i < 2; ++i) { int R, C; stage_rc(tid * 16 + i * 8192, R, C); const int Rb = Epi::PERM ? ((R & ~31) + perm32(R & 31)) : R;
        voffA[i] = (unsigned)(R * K * esz + C * 2); voffB[i] = (unsigned)(Rb * K * esz + C * 2); }
    const size_t kstep = (size_t)(BK * 2);
    const size_t hstep = (size_t)HALF * K * esz;
    static_assert(!A2T || (SPLIT2 && SP2 && !F8), "A2T needs the SPLIT2 SP2 bf16 body");
    unsigned voffA2[2], aT[4]; (void)voffA2; (void)aT;
    const size_t ldt = (size_t)g.M * 2;
    if constexpr (A2T) {
#pragma unroll
        for (int i = 0; i < 2; ++i) { const int p = tid * 16 + i * 8192, k = p >> 8, ck = (p >> 4) & 15, grp = (ck >> 1) ^ ((k & 3) | ((k >> 1) & 4)); voffA2[i] = (unsigned)((size_t)k * ldt + (size_t)(16 * grp + 8 * (ck & 1)) * 2); }
        const int q = fr >> 2, p4 = fr & 3;
#pragma unroll
        for (int m = 0; m < 4; ++m) aT[m] = (unsigned)(256 * (8 * fq + q) + 32 * ((4 * wr + m) ^ (q | ((fq & 1) << 2))) + 8 * p4);
    }
    const size_t kstep2 = A2T ? (size_t)BK * ldt : (size_t)(BK * 2), hstepA2 = A2T ? (size_t)256 : hstep, tstepA2 = A2T ? (size_t)512 : 2 * hstep;
    const size_t tstep = 2 * hstep;
    const unsigned ldsw = (unsigned)wid * 1024u;
    const int aoff = lds_byte(wr * 64 + fr, fq * 8), boff = lds_byte(wc * 32 + fr, fq * 8);
#define PG8_SA(b, h) (((b) * 2 + (h)) * HTB)
#define PG8_SB(b, h) ((4 + (b) * 2 + (h)) * HTB)
#define PG8_STAGE(bufoff, gbase, voff) do { _Pragma("unroll") for (int _i = 0; _i < 2; ++_i) \
        __builtin_amdgcn_global_load_lds((const unsigned*)((const char*)(gbase) + (voff)[_i]), (PG8_LAS unsigned*)(lds + (bufoff) + ldsw + _i * 8192), 16, 0, 0); } while (0)
#define PG8_LDA(dst, b, h) do { if constexpr (F8) { _Pragma("unroll") for (int m = 0; m < 4; ++m) { dst##8[m].lo = *(const PG8_LAS i32x4*)(lds + PG8_SA(b, h) + aoff + m * 2048); dst##8[m].hi = *(const PG8_LAS i32x4*)(lds + PG8_SA(b, h) + aoff + m * 2048 + 1024); } } else { \
        if (A2T && trm) { _Pragma("unroll") for (int m = 0; m < 4; ++m) _Pragma("unroll") for (int k = 0; k < 2; ++k) { \
            const s16x4 lo_ = __builtin_amdgcn_ds_read_tr16_b64_v4i16((PG8_LAS s16x4*)(lds + PG8_SA(b, h) + aT[m] + k * 8192)), hi_ = __builtin_amdgcn_ds_read_tr16_b64_v4i16((PG8_LAS s16x4*)(lds + PG8_SA(b, h) + aT[m] + k * 8192 + 1024)); \
            dst[m][k] = __builtin_shufflevector(lo_, hi_, 0, 1, 2, 3, 4, 5, 6, 7); } } else { \
        _Pragma("unroll") for (int m = 0; m < 4; ++m) _Pragma("unroll") for (int k = 0; k < 2; ++k) dst[m][k] = *(const PG8_LAS bf16x8*)(lds + PG8_SA(b, h) + aoff + m * 2048 + k * 1024); } } } while (0)
#define PG8_LDB(dst, b, h) do { if constexpr (F8) { _Pragma("unroll") for (int n = 0; n < 2; ++n) { dst##8[n].lo = *(const PG8_LAS i32x4*)(lds + PG8_SB(b, h) + boff + n * 2048); dst##8[n].hi = *(const PG8_LAS i32x4*)(lds + PG8_SB(b, h) + boff + n * 2048 + 1024); } } else { \
        _Pragma("unroll") for (int n = 0; n < 2; ++n) _Pragma("unroll") for (int k = 0; k < 2; ++k) dst[n][k] = *(const PG8_LAS bf16x8*)(lds + PG8_SB(b, h) + boff + n * 2048 + k * 1024); } } while (0)
#define PG8_MMA(ai, bj, At, Bt) do { __builtin_amdgcn_s_setprio(1); if constexpr (F8) { asm volatile("s_nop 1"); _Pragma("unroll") for (int m = 0; m < 4; ++m) _Pragma("unroll") for (int n = 0; n < 2; ++n) \
            asm volatile("v_mfma_scale_f32_16x16x128_f8f6f4 %0, %1, %2, %0, %3, %4 op_sel_hi:[0,0,0]" : "+v"(acc[ai][bj][m][n]) : "v"(Bt##8[n]), "v"(At##8[m]), "v"(sb_), "v"(sa_)); } else { \
        _Pragma("unroll") for (int m = 0; m < 4; ++m) _Pragma("unroll") for (int n = 0; n < 2; ++n) _Pragma("unroll") for (int k = 0; k < 2; ++k) \
        acc[ai][bj][m][n] = __builtin_amdgcn_mfma_f32_16x16x32_bf16(Bt[n][k], At[m][k], acc[ai][bj][m][n], 0, 0, 0); } __builtin_amdgcn_s_setprio(0); } while (0)
#define PG8_WAIT_V(n) asm volatile("s_waitcnt vmcnt(" #n ")" ::: "memory")
#define PG8_WAIT_L(n) asm volatile("s_waitcnt lgkmcnt(" #n ")" ::: "memory")
#define PG8_BAR __builtin_amdgcn_s_barrier()
#define PG8_SCHED __builtin_amdgcn_sched_barrier(0)
    Unit cur, nxt; int ui = 0;
    if (!S.next(0, cur)) return;
    f32x4 acc[2][2][4][2];
#pragma unroll
    for (int a = 0; a < 2; ++a)
#pragma unroll
        for (int b = 0; b < 2; ++b)
#pragma unroll
            for (int m = 0; m < 4; ++m)
#pragma unroll
                for (int n = 0; n < 2; ++n) acc[a][b][m][n] = (f32x4){0.f, 0.f, 0.f, 0.f};
    bf16x8 At[4][2], B0[2][2], B1[2][2]; i32x8 At8[4], B08[2], B18[2]; (void)At; (void)B0; (void)B1; (void)At8; (void)B08; (void)B18;
    const char* cA = (const char*)g.A + (size_t)cur.pm * tstep; const char* cB = (const char*)g.Bt + (size_t)cur.pn * tstep;
    const char* cA2 = SPLIT2 ? (const char*)g.A2 + (size_t)cur.pm * tstepA2 : cA; const char* cB2 = SPLIT2 ? (const char*)g.B2t + (size_t)cur.pn * tstep : cB; (void)cA2; (void)cB2;
#define PG8_TA(kt) ((SPLIT2 && (kt) >= nh) ? cA2 + (size_t)((kt) - nh) * kstep2 : cA + (size_t)(kt) * kstep)
#define PG8_STAGE_A(b, h, base, sec) do { if constexpr (A2T) { if (sec) PG8_STAGE(PG8_SA(b, h), (base) + (h) * hstepA2, voffA2); else PG8_STAGE(PG8_SA(b, h), (base) + (h) * hstep, voffA); } else PG8_STAGE(PG8_SA(b, h), (base) + (h) * hstep, voffA); } while (0)
#define PG8_TB(kt) ((SPLIT2 && (kt) >= nh) ? cB2 + (size_t)((kt) - nh) * kstep : cB + (size_t)(kt) * kstep)
    S.a_ready(cur);
    if constexpr (SP2) {
        PG8_STAGE(PG8_SB(0, 0), cB, voffB); PG8_STAGE(PG8_SB(0, 1), cB + hstep, voffB); PG8_STAGE(PG8_SA(0, 0), cA, voffA); PG8_STAGE(PG8_SA(0, 1), cA + hstep, voffA);
        if (wr == 1) PG8_BAR;
        PG8_WAIT_V(2); PG8_BAR;
        PG8_STAGE(PG8_SB(1, 0), cB + kstep, voffB); PG8_STAGE(PG8_SA(1, 0), cA + kstep, voffA); PG8_STAGE(PG8_SB(1, 1), cB + hstep + kstep, voffB);
        PG8_WAIT_V(6); PG8_BAR;
    } else {
        PG8_STAGE(PG8_SB(0, 0), cB, voffB); PG8_STAGE(PG8_SA(0, 0), cA, voffA); PG8_STAGE(PG8_SB(0, 1), cB + hstep, voffB); PG8_STAGE(PG8_SA(0, 1), cA + hstep, voffA);
        if (wr == 1) PG8_BAR;
        PG8_WAIT_V(4); PG8_BAR;
        PG8_STAGE(PG8_SB(1, 0), cB + kstep, voffB); PG8_STAGE(PG8_SA(1, 0), cA + kstep, voffA); PG8_STAGE(PG8_SB(1, 1), cB + hstep + kstep, voffB);
        PG8_WAIT_V(6); PG8_BAR;
    }
    for (;;) {
        const bool has_next = S.next(ui + 1, nxt);
        const char* nA = has_next ? (const char*)g.A + (size_t)nxt.pm * tstep : cA; const char* nB = has_next ? (const char*)g.Bt + (size_t)nxt.pn * tstep : cB;
        for (int t = 0; t < nt; t += 2) {
            const bool last = (t == nt - 2);
            if constexpr (SPLIT2) { if (t == nh) E.mid(acc, cur, wr, wc, fr, fq); }
            const char* a1 = PG8_TA(t + 1);
            const char* a2 = last ? nA : PG8_TA(t + 2); const char* b2 = last ? nB : PG8_TB(t + 2);
            const bool s1 = A2T && (t + 1 >= nh), s2 = A2T && !last && (t + 2 >= nh), trm = A2T && (t >= nh); (void)s1; (void)s2; (void)trm;
            const char* a3 = a2 + (s2 ? kstep2 : kstep); const char* b3 = b2 + kstep;
            if (last && has_next) S.a_ready(nxt);
            if constexpr (SP2) {
            PG8_LDB(B0, 0, 0); PG8_LDB(B1, 0, 1); PG8_SCHED; PG8_LDA(At, 0, 0); PG8_STAGE_A(1, 1, a1, s1);
            PG8_WAIT_V(8); PG8_WAIT_L(0); PG8_BAR; PG8_MMA(0, 0, At, B0); PG8_MMA(0, 1, At, B1); PG8_BAR; PG8_SCHED;
            PG8_LDA(At, 0, 1); PG8_STAGE(PG8_SB(0, 0), b2, voffB); PG8_STAGE(PG8_SB(0, 1), b2 + hstep, voffB); PG8_STAGE_A(0, 0, a2, s2);
            PG8_WAIT_V(8); PG8_WAIT_L(0); PG8_BAR; PG8_MMA(1, 0, At, B0); PG8_MMA(1, 1, At, B1); PG8_BAR; PG8_SCHED;
            PG8_LDB(B0, 1, 0); PG8_LDB(B1, 1, 1); PG8_SCHED; PG8_LDA(At, 1, 0); PG8_STAGE_A(0, 1, a2, s2);
            PG8_WAIT_V(8); PG8_WAIT_L(0); PG8_BAR; PG8_MMA(0, 0, At, B0); PG8_MMA(0, 1, At, B1); PG8_BAR; PG8_SCHED;
            PG8_LDA(At, 1, 1); PG8_STAGE(PG8_SB(1, 0), b3, voffB); PG8_STAGE(PG8_SB(1, 1), b3 + hstep, voffB); PG8_STAGE_A(1, 0, a3, s2);
            PG8_WAIT_V(8); PG8_WAIT_L(0); PG8_BAR; PG8_MMA(1, 0, At, B0); PG8_MMA(1, 1, At, B1); PG8_BAR; PG8_SCHED;
            } else {
            PG8_LDB(B0, 0, 0); PG8_SCHED; PG8_LDA(At, 0, 0); PG8_STAGE(PG8_SA(1, 1), a1 + hstep, voffA);
            PG8_WAIT_L(8); PG8_BAR; PG8_WAIT_L(0); PG8_MMA(0, 0, At, B0); PG8_BAR; PG8_SCHED;
            PG8_LDB(B1, 0, 1); PG8_STAGE(PG8_SB(0, 0), b2, voffB);
            PG8_BAR; PG8_WAIT_L(0); PG8_MMA(0, 1, At, B1); PG8_BAR;
            PG8_LDA(At, 0, 1); PG8_STAGE(PG8_SA(0, 0), a2, voffA);
            PG8_BAR; PG8_WAIT_L(0); PG8_MMA(1, 0, At, B0); PG8_BAR; PG8_SCHED;
            PG8_STAGE(PG8_SB(0, 1), b2 + hstep, voffB);
            PG8_WAIT_V(6); PG8_BAR; PG8_MMA(1, 1, At, B1); PG8_BAR;
            PG8_LDB(B0, 1, 0); PG8_SCHED; PG8_LDA(At, 1, 0); PG8_STAGE(PG8_SA(0, 1), a2 + hstep, voffA);
            PG8_WAIT_L(8); PG8_BAR; PG8_WAIT_L(0); PG8_MMA(0, 0, At, B0); PG8_BAR; PG8_SCHED;
            PG8_LDB(B1, 1, 1); PG8_STAGE(PG8_SB(1, 0), b3, voffB);
            PG8_BAR; PG8_WAIT_L(0); PG8_MMA(0, 1, At, B1); PG8_BAR;
            PG8_LDA(At, 1, 1); PG8_STAGE(PG8_SA(1, 0), a3, voffA);
            PG8_BAR; PG8_WAIT_L(0); PG8_MMA(1, 0, At, B0); PG8_BAR; PG8_SCHED;
            PG8_STAGE(PG8_SB(1, 1), b3 + hstep, voffB);
            PG8_WAIT_V(6); PG8_BAR; PG8_MMA(1, 1, At, B1); PG8_BAR;
            }
        }
        if constexpr (F8) asm volatile("s_nop 15\n\ts_nop 15\n\ts_nop 7" ::: "memory");
        if constexpr (ALIGN_EPI) { if (wr == 0) PG8_BAR; }
        if constexpr (!Epi::AFTER_DRAIN) { E(acc, cur, wr, wc, fr, fq); S.done(cur); }
        if (!has_next) break;
#pragma unroll
        for (int a = 0; a < 2; ++a)
#pragma unroll
            for (int b = 0; b < 2; ++b)
#pragma unroll
                for (int m = 0; m < 4; ++m)
#pragma unroll
                    for (int n = 0; n < 2; ++n) acc[a][b][m][n] = (f32x4){0.f, 0.f, 0.f, 0.f};
        cur = nxt; cA = nA; cB = nB; ++ui;
        if constexpr (SPLIT2) { cA2 = (const char*)g.A2 + (size_t)cur.pm * tstepA2; cB2 = (const char*)g.B2t + (size_t)cur.pn * tstep; }
        if constexpr (ALIGN_EPI) { if (wr == 1) PG8_BAR; }
    }
    PG8_WAIT_V(0);
    if constexpr (!ALIGN_EPI) { if (wr == 0) PG8_BAR; }
    PG8_BAR;
    if constexpr (Epi::AFTER_DRAIN) { E.fused(acc, cur, wr, wc, fr, fq, lds, wid, lane); S.done(cur); }
#undef PG8_TA
#undef PG8_STAGE_A
#undef PG8_TB
#undef PG8_SA
#undef PG8_SB
#undef PG8_STAGE
#undef PG8_LDA
#undef PG8_LDB
#undef PG8_MMA
#undef PG8_WAIT_V
#undef PG8_WAIT_L
#undef PG8_BAR
#undef PG8_SCHED
}
}

constexpr int NB = 16, SEQ = 4096, D = 1024, T = NB * SEQ, PROJ = 8192, DFF = 2816, DFE = 3584, NE = 8, NLAYER = 2;
constexpr int CHT = 16384;
constexpr int NCH = T / CHT;
constexpr int CH_ROWS = 2 * CHT + 2048;
constexpr float LN_EPS = 1e-5f;
constexpr float ALPHA = 1.41421356237f;
constexpr int NWAVES = 8, NTHR = 512;

constexpr size_t MiB = 1u << 20;
constexpr size_t WS_CTL = 0, CTL_ZERO_BYTES = 1 * MiB;
constexpr size_t WS_WINT = 1 * MiB;
constexpr size_t WS_WAT = 33 * MiB, WS_WHT = 37 * MiB, WS_WOT = 41 * MiB;
constexpr size_t WS_W13 = 45 * MiB;
constexpr size_t WS_W2 = 56 * MiB;
constexpr size_t WS_H2 = 62 * MiB;
constexpr size_t WS_KFR = 64 * MiB;
constexpr size_t WS_EID = 96 * MiB;
constexpr size_t WS_WGT = 97 * MiB;
constexpr size_t WS_POS = 98 * MiB;
constexpr size_t WS_POS2 = 98 * MiB + 512 * 1024;
constexpr size_t WS_BCNT = 99 * MiB;
constexpr size_t WS_TAB = 99 * MiB + 65536;
constexpr size_t WS_SB = 100 * MiB;
constexpr size_t WS_H8F = 440 * MiB;
constexpr size_t WING_OFF = 12 * MiB;
constexpr size_t WS_H = 128 * MiB;
constexpr size_t WS_S1 = 256 * MiB, WS_S2 = 384 * MiB, WS_S3 = 512 * MiB, WS_S4 = 640 * MiB, WS_S5 = 768 * MiB, WS_S6 = 896 * MiB;
constexpr size_t WS_ACT0 = 256 * MiB;
constexpr size_t OUT_MW13 = 0, OUT_MW2 = 200 * MiB;
constexpr size_t WS_Y = 256 * MiB;
constexpr size_t WS_HP8 = 528 * MiB;
constexpr size_t WS_ACT8 = 664 * MiB;
constexpr size_t ACT8_BYTES = (size_t)CH_ROWS * DFE;
constexpr float F8_H = 4.f, F8_W13 = 64.f, F8_ACT = 8.f, F8_W2 = 256.f;
constexpr int E8_H = 0x7D7D7D7D, E8_W13 = 0x79797979, E8_ACT = 0x7C7C7C7C, E8_W2 = 0x77777777;
constexpr size_t WS_END = 1024 * MiB;
static_assert(WS_Y + (size_t)NCH * CH_ROWS * D * 2 <= WS_HP8 && WS_HP8 + (size_t)NCH * CH_ROWS * D <= WS_ACT8 && WS_ACT8 + 2 * ACT8_BYTES <= WS_END, "ws map");
constexpr float SWG_W1 = -1.44269504f, SWG_W3 = -0.69314718f * F8_ACT;
constexpr int CW_BAR = 4096;

constexpr int RING_BYTES = 131072, MISC_OFF = RING_BYTES + 320, LDS_BYTES = 147456;

#define GAS __attribute__((address_space(1)))
#define LAS __attribute__((address_space(3)))
typedef unsigned short bf16;
typedef float f32x4 __attribute__((ext_vector_type(4)));
typedef unsigned u32x4 __attribute__((ext_vector_type(4)));
typedef unsigned u32x2 __attribute__((ext_vector_type(2)));
typedef short bf16x8 __attribute__((ext_vector_type(8)));
using pg8::cvt_pk_bf16; using pg8::bflo; using pg8::bfhi;

#define XB_TMO      128
#define XB_XCNT(j)  (256  + 64 * (j))
#define XB_XSUB(j)  (1280 + 64 * (j))
#define XB_XGEN(j)  (2304 + 64 * (j))
#define XB_TOP      3328
#define XB_TOPGEN   3392
#define XCD_BAR_WORDS 3456
#define XB_SPIN_CAP (1u << 18)
__device__ __forceinline__ unsigned xb_ld(unsigned* p)              { return __hip_atomic_load(p, __ATOMIC_RELAXED, __HIP_MEMORY_SCOPE_AGENT); }
__device__ __forceinline__ unsigned xb_add(unsigned* p, unsigned v) { return __hip_atomic_fetch_add(p, v, __ATOMIC_RELAXED, __HIP_MEMORY_SCOPE_AGENT); }
__device__ __forceinline__ unsigned xb_xcc_id() { return (unsigned)__builtin_amdgcn_s_getreg((3 << 11) | 20) & 0xFu; }
#define XB_SPIN(cond, bar) do { unsigned _sp = 0; while (cond) { __builtin_amdgcn_s_sleep(1); \
    if ((++_sp & 255u) == 0u) { if (xb_ld(&(bar)[XB_TMO])) break; if (_sp > XB_SPIN_CAP) { atomicAdd(&(bar)[XB_TMO], 1u); break; } } } } while (0)
struct XcdBarrier { unsigned* bar; unsigned x; volatile LAS unsigned* st; };
__device__ __forceinline__ XcdBarrier xcd_barrier_post(unsigned* bar, volatile LAS unsigned* st) {
    XcdBarrier b; b.bar = bar; b.x = xb_xcc_id(); b.st = st;
    if (threadIdx.x == 0) (void)xb_add(&bar[XB_XCNT(b.x)], 1u);
    return b;
}
__device__ __forceinline__ void xcd_barrier_complete(unsigned* bar, unsigned x, unsigned& nloc, unsigned& nx) {
    const unsigned G = gridDim.x * gridDim.y * gridDim.z;
    unsigned sum, cnt, mine, sp = 0u;
    for (;;) {
        sum = 0u; cnt = 0u; mine = 0u;
#pragma unroll
        for (unsigned j = 0; j < 16; ++j) { const unsigned c = xb_ld(&bar[XB_XCNT(j)]); sum += c; cnt += (c > 0u) ? 1u : 0u; mine = (j == x) ? c : mine; }
        if (sum == G) break;
        __builtin_amdgcn_s_sleep(1);
        if ((++sp & 255u) == 0u) { if (xb_ld(&bar[XB_TMO])) break; if (sp > XB_SPIN_CAP) { atomicAdd(&bar[XB_TMO], 1u); break; } }
    }
    nloc = mine > 0u ? mine : 1u; nx = cnt > 0u ? cnt : 1u;
}
__device__ __forceinline__ void xcd_barrier(const XcdBarrier& b) {
    asm volatile("s_waitcnt vmcnt(0)" ::: "memory");
    __syncthreads();
    if (threadIdx.x == 0) {
        unsigned* bar = b.bar;
        __builtin_amdgcn_s_waitcnt(0);
        unsigned nloc = b.st[0], nx = b.st[1];
        if (nloc == 0u) { xcd_barrier_complete(bar, b.x, nloc, nx); b.st[0] = nloc; b.st[1] = nx; }
        const unsigned old = xb_add(&bar[XB_XSUB(b.x)], 1u);
        const unsigned gen = old / nloc;
        if (old + 1u == (gen + 1u) * nloc) {
            __builtin_amdgcn_fence(__ATOMIC_RELEASE, "agent");
            asm volatile("s_waitcnt vmcnt(0)" ::: "memory");
            const unsigned og = xb_add(&bar[XB_TOP], 1u);
            const unsigned tg = og / nx;
            if (og + 1u == (tg + 1u) * nx) xb_add(&bar[XB_TOPGEN], 1u);
            else XB_SPIN(xb_ld(&bar[XB_TOPGEN]) == tg, bar);
            __builtin_amdgcn_fence(__ATOMIC_ACQUIRE, "agent");
            xb_add(&bar[XB_XGEN(b.x)], 1u);
            asm volatile("s_waitcnt vmcnt(0)" ::: "memory");
        } else {
            XB_SPIN(xb_ld(&bar[XB_XGEN(b.x)]) == gen, bar);
            __builtin_amdgcn_fence(__ATOMIC_ACQUIRE, "agent");
            asm volatile("s_waitcnt vmcnt(0)" ::: "memory");
        }
    }
    __syncthreads();
}

#define GB_CNT(g) (3584 + 64 * (g))
__device__ __forceinline__ void grp_barrier(unsigned* bar, unsigned grp, unsigned nmem, unsigned& gen) {
    asm volatile("s_waitcnt vmcnt(0)" ::: "memory");
    __syncthreads();
    if (threadIdx.x == 0) {
        __builtin_amdgcn_s_waitcnt(0);
        __builtin_amdgcn_fence(__ATOMIC_RELEASE, "agent");
        asm volatile("s_waitcnt vmcnt(0)" ::: "memory");
        (void)xb_add(&bar[GB_CNT(grp)], 1u);
        const unsigned target = (gen + 1u) * nmem;
        XB_SPIN(xb_ld(&bar[GB_CNT(grp)]) < target, bar);
        __builtin_amdgcn_fence(__ATOMIC_ACQUIRE, "agent");
        asm volatile("s_waitcnt vmcnt(0)" ::: "memory");
    }
    ++gen;
    __syncthreads();
}

struct Args { const float* in[28]; float* out; unsigned char* ws; int ph_lo, ph_hi; };
enum { I_X = 0, I_LNING, I_LNINB, I_WIN, I_CAW, I_CHW, I_CHB, I_FW1, I_FB1, I_FFREQ, I_FW2, I_FB2, I_FW3, I_HBIAS, I_WA, I_WH, I_WO, I_LNMG, I_LNMB, I_F1, I_F3, I_F2, I_ROUTER, I_M1, I_M3, I_M2, I_LNFG, I_LNFB };
struct Frame {
    LAS unsigned char* lds;
    int tid, lane, wave, G, gw, NGW;
    const float* const* in; float* out; unsigned char* ws;
    int it0; bool loc;
};
__device__ __forceinline__ float wave_sum(float v) {
#pragma unroll
    for (int o = 1; o < 64; o <<= 1) v += __shfl_xor(v, o);
    return v;
}
__device__ __forceinline__ void unpack8(const u32x4 q, float (&f)[8]) { f[0] = bflo(q.x); f[1] = bfhi(q.x); f[2] = bflo(q.y); f[3] = bfhi(q.y); f[4] = bflo(q.z); f[5] = bfhi(q.z); f[6] = bflo(q.w); f[7] = bfhi(q.w); }
__device__ __forceinline__ u32x4 pack8f(const float (&f)[8]) { u32x4 w; w.x = cvt_pk_bf16(f[0], f[1]); w.y = cvt_pk_bf16(f[2], f[3]); w.z = cvt_pk_bf16(f[4], f[5]); w.w = cvt_pk_bf16(f[6], f[7]); return w; }
__device__ __forceinline__ unsigned f2bf(float f) { return cvt_pk_bf16(f, 0.f) & 0xffffu; }

struct TrItem { const float* W; bf16* WT; int K, N, sel, idx; float f8s; float mul = 1.f; };
__device__ __forceinline__ void tr_load(const TrItem& t, int lane, f32x4 (&v)[8]) {
    const int nblk = t.N / 32, kb = t.idx / nblk, nb = t.idx % nblk, k0 = 64 * kb, n0 = 32 * nb;
#pragma unroll
    for (int i = 0; i < 8; ++i) v[i] = __builtin_nontemporal_load((const f32x4*)(t.W + (size_t)(k0 + 8 * i + (lane >> 3)) * t.N + n0 + 4 * (lane & 7)));
}
__device__ __forceinline__ void tr_store(const TrItem& t, int lane, LAS float* scr, const f32x4 (&v)[8]) {
    const int nblk = t.N / 32, kb = t.idx / nblk, nb = t.idx % nblk, k0 = 64 * kb, n0 = 32 * nb, sel = t.sel;
    int r0 = n0, hi16 = 16;
    if (sel == 0 || sel == 1) r0 = 256 * (n0 >> 7) + 128 * sel + (n0 & 127);
    if (sel == 2) { const int secg = n0 >> 10, cha = n0 & 1023, blk = cha >> 6, ch0 = cha & 63; int tile, bj, n;
        if (secg == 3 || secg == 4) { tile = 16 + (blk >> 1); bj = blk & 1; n = (secg == 4) ? 1 : 0; }
        else if (secg >= 6) { tile = blk >> 1; bj = blk & 1; n = (secg == 7) ? 1 : 0; }
        else { const int sec = (secg == 5) ? 3 : secg; tile = blk; bj = sec >> 1; n = sec & 1; }
        r0 = 256 * tile + 128 * bj + 32 * (ch0 >> 4) + 16 * n; hi16 = 32; }
#pragma unroll
    for (int i = 0; i < 8; ++i) { LAS float* d = scr + (8 * i + (lane >> 3)) * 33 + 4 * (lane & 7); d[0] = v[i].x; d[1] = v[i].y; d[2] = v[i].z; d[3] = v[i].w; }
    asm volatile("s_waitcnt lgkmcnt(0)" ::: "memory");
    const int c = lane & 7;
#pragma unroll
    for (int j = 0; j < 4; ++j) { const int n = (lane >> 3) + 8 * j; const LAS float* s = scr + (8 * c) * 33 + n;
        const float mu = t.mul; u32x4 o; o.x = cvt_pk_bf16(s[0 * 33] * mu, s[1 * 33] * mu); o.y = cvt_pk_bf16(s[2 * 33] * mu, s[3 * 33] * mu); o.z = cvt_pk_bf16(s[4 * 33] * mu, s[5 * 33] * mu); o.w = cvt_pk_bf16(s[6 * 33] * mu, s[7 * 33] * mu);
        if (t.f8s != 0.f) { const float f = t.f8s; unsigned a = 0, b = 0;
            a = __builtin_amdgcn_cvt_pk_fp8_f32(s[0 * 33] * f, s[1 * 33] * f, a, false); a = __builtin_amdgcn_cvt_pk_fp8_f32(s[2 * 33] * f, s[3 * 33] * f, a, true);
            b = __builtin_amdgcn_cvt_pk_fp8_f32(s[4 * 33] * f, s[5 * 33] * f, b, false); b = __builtin_amdgcn_cvt_pk_fp8_f32(s[6 * 33] * f, s[7 * 33] * f, b, true);
            *(u32x2*)((unsigned char*)t.WT + (size_t)(r0 + (n & 15) + hi16 * (n >> 4)) * t.K + k0 + 8 * c) = (u32x2){a, b}; }
        else *(u32x4*)(t.WT + (size_t)(r0 + (n & 15) + hi16 * (n >> 4)) * t.K + k0 + 8 * c) = o; }
    asm volatile("s_waitcnt lgkmcnt(0)" ::: "memory");
}
#define TR_LOOP(NIT, DEC) for (int it_ = F.gw; it_ < (NIT); it_ += 2 * F.NGW) { const TrItem ta_ = DEC(it_); const bool hb_ = it_ + F.NGW < (NIT); const TrItem tb_ = DEC(hb_ ? it_ + F.NGW : it_); \
        f32x4 va_[8], vb_[8]; tr_load(ta_, F.lane, va_); if (hb_) tr_load(tb_, F.lane, vb_); tr_store(ta_, F.lane, scr, va_); if (hb_) tr_store(tb_, F.lane, scr, vb_); }

__device__ __forceinline__ void ln_apply(f32x4 (&v)[4], const f32x4 (&g)[4], const f32x4 (&b)[4]) {
    float s = 0.f;
#pragma unroll
    for (int j = 0; j < 4; ++j) s += (v[j].x + v[j].y) + (v[j].z + v[j].w);
    const float mean = wave_sum(s) * (1.f / D); float s2 = 0.f;
#pragma unroll
    for (int j = 0; j < 4; ++j) { v[j] = v[j] - mean; s2 += (v[j].x * v[j].x + v[j].y * v[j].y) + (v[j].z * v[j].z + v[j].w * v[j].w); }
    const float rstd = 1.f / sqrtf(wave_sum(s2) * (1.f / D) + LN_EPS);
#pragma unroll
    for (int j = 0; j < 4; ++j) v[j] = v[j] * rstd * g[j] + b[j];
}
template <int R, bool LGB = false> __device__ __forceinline__ void ln_rows(f32x4 (&v)[R][4], const f32x4 (&g)[4], const f32x4 (&b)[4], const LAS f32x4* gl = nullptr, int lane = 0) {
    float s[R];
#pragma unroll
    for (int r = 0; r < R; ++r) { s[r] = 0.f;
#pragma unroll
        for (int j = 0; j < 4; ++j) s[r] += (v[r][j].x + v[r][j].y) + (v[r][j].z + v[r][j].w); }
#pragma unroll
    for (int o = 1; o < 64; o <<= 1)
#pragma unroll
        for (int r = 0; r < R; ++r) s[r] += __shfl_xor(s[r], o);
    float q[R];
#pragma unroll
    for (int r = 0; r < R; ++r) { const float mean = s[r] * (1.f / D); q[r] = 0.f;
#pragma unroll
        for (int j = 0; j < 4; ++j) { v[r][j] = v[r][j] - mean; q[r] += (v[r][j].x * v[r][j].x + v[r][j].y * v[r][j].y) + (v[r][j].z * v[r][j].z + v[r][j].w * v[r][j].w); } }
#pragma unroll
    for (int o = 1; o < 64; o <<= 1)
#pragma unroll
        for (int r = 0; r < R; ++r) q[r] += __shfl_xor(q[r], o);
#pragma unroll
    for (int r = 0; r < R; ++r) { const float rstd = 1.f / sqrtf(q[r] * (1.f / D) + LN_EPS);
#pragma unroll
        for (int j = 0; j < 4; ++j) { if (LGB) v[r][j] = v[r][j] * rstd * gl[lane + 64 * j] + gl[256 + lane + 64 * j]; else v[r][j] = v[r][j] * rstd * g[j] + b[j]; } }
}
__device__ __forceinline__ void store_row_bf16(bf16* orow, int lane, const f32x4 (&v)[4]) {
    u32x2* o8 = (u32x2*)orow + lane;
#pragma unroll
    for (int j = 0; j < 4; ++j) { u32x2 w; w.x = cvt_pk_bf16(v[j].x, v[j].y); w.y = cvt_pk_bf16(v[j].z, v[j].w); o8[64 * j] = w; }
}

__device__ __forceinline__ void ph_prologue_a(Frame& F) {
    LAS float* scr = (LAS float*)(F.lds + F.wave * 16384);
    unsigned char* ws = F.ws;
    constexpr int I_WIN_N = (D / 64) * (PROJ / 32), I_SQ = (D / 64) * (D / 32), I_F13 = (D / 64) * (DFF / 32), I_F2N = (DFF / 64) * (D / 32);
    constexpr int NITEMS = 2 * I_WIN_N + 6 * I_SQ + 2 * I_F13 + I_F2N;
    auto dec = [&](int it) -> TrItem { int r = it; TrItem t;
        if (r < 2 * I_WIN_N) { const int l = r / I_WIN_N; const bool gate = ((r % I_WIN_N) % (PROJ / 32)) >= 6 * (D / 32);
            t = TrItem{F.in[I_WIN] + (size_t)l * D * PROJ, (bf16*)(ws + WS_WINT + (size_t)l * PROJ * D * 2 + (gate ? WING_OFF : 0)), D, PROJ, 2, r % I_WIN_N, gate ? F8_W13 * SWG_W1 : 0.f, 1.f}; return t; }     r -= 2 * I_WIN_N;
        if (r < 6 * I_SQ) { const int w = r / I_SQ, l = w & 1, which = w >> 1; const float* src = F.in[which == 0 ? I_WA : (which == 1 ? I_WH : I_WO)] + (size_t)l * D * D;
            bf16* dst = (bf16*)(ws + (which == 0 ? WS_WAT : (which == 1 ? WS_WHT : WS_WOT))) + (size_t)l * D * D; t = TrItem{src, dst, D, D, -1, r % I_SQ, 0.f}; return t; } r -= 6 * I_SQ;
        if (r < 2 * I_F13) { const int sel = r / I_F13; t = TrItem{F.in[sel == 0 ? I_F1 : I_F3], (bf16*)(ws + WS_W13), D, DFF, sel, r % I_F13, F8_W13 * (sel == 0 ? SWG_W1 : SWG_W3)}; return t; } r -= 2 * I_F13;
        t = TrItem{F.in[I_F2], (bf16*)(ws + WS_W2), DFF, D, -1, r, F8_W2}; return t; };
    TR_LOOP(NITEMS, dec)
    { f32x4 g[4], b[4];
#pragma unroll
      for (int j = 0; j < 4; ++j) { g[j] = ((const f32x4*)F.in[I_LNING])[F.lane + 64 * j]; b[j] = ((const f32x4*)F.in[I_LNINB])[F.lane + 64 * j]; }
      for (int m0 = F.gw * 4; m0 < T; m0 += F.NGW * 4) { f32x4 v[4][4];
#pragma unroll
          for (int r = 0; r < 4; ++r) { const f32x4* xr = (const f32x4*)(F.in[I_X] + (size_t)(m0 + r) * D) + F.lane;
#pragma unroll
              for (int j = 0; j < 4; ++j) v[r][j] = __builtin_nontemporal_load(&xr[64 * j]); }
          ln_rows<4>(v, g, b);
#pragma unroll
          for (int r = 0; r < 4; ++r) { store_row_bf16((bf16*)(ws + WS_H) + (size_t)(m0 + r) * D, F.lane, v[r]);
              unsigned* h8 = (unsigned*)(ws + WS_H8F + (size_t)(m0 + r) * D) + F.lane;
#pragma unroll
              for (int j = 0; j < 4; ++j) { unsigned a = 0; a = __builtin_amdgcn_cvt_pk_fp8_f32(v[r][j].x * F8_H, v[r][j].y * F8_H, a, false); a = __builtin_amdgcn_cvt_pk_fp8_f32(v[r][j].z * F8_H, v[r][j].w * F8_H, a, true); h8[64 * j] = a; } } } }
    for (int it = F.gw; it < NLAYER * SEQ; it += F.NGW) {
        const int l = it / SEQ, t = it % SEQ, u = F.lane;
        const float* w1 = F.in[I_FW1] + (size_t)l * 33 * 64; const float* w2 = F.in[I_FW2] + (size_t)l * 64 * 64;
        const float fr = F.in[I_FFREQ][l * 64 + u];
        const float tn = (float)t / (float)(SEQ - 1);
        float a = tn * w1[u];
        for (int k = 0; k < 16; ++k) { const float band = 1e-4f + (15.0f - 1e-4f) * (float)k / 15.0f; const float rev = band * ((float)t / (float)SEQ);
            const float fr_ = rev - floorf(rev);
            a += __builtin_amdgcn_cosf(fr_) * w1[(1 + k) * 64 + u] - __builtin_amdgcn_sinf(fr_) * w1[(17 + k) * 64 + u]; }
        const float h1 = __sinf(fr * (a + F.in[I_FB1][l * 64 + u]));
        float a2 = 0.f;
        for (int k = 0; k < 64; ++k) a2 += __shfl(h1, k) * w2[k * 64 + u];
        const float h2 = __sinf(fr * (a2 + F.in[I_FB2][l * 64 + u]));
        ((float*)(ws + WS_H2))[(size_t)it * 64 + u] = h2;
    }
}
__device__ __forceinline__ void ph_prologue_b(Frame& F) {
    unsigned char* ws = F.ws;
    const float maxd = logf(1e-2f) / 0.3f, mind = logf(1e-2f) / 1.5f;
    LAS float* tile = (LAS float*)F.lds;
    for (int grp = blockIdx.x; grp < NLAYER * 2 * D / NWAVES; grp += F.G) {
        const int it = grp * NWAVES + F.wave;
        const int l = it / (2 * D), col = it % (2 * D), dir = col / D, c = col % D;
        const float* w3 = F.in[I_FW3] + (size_t)l * 64 * 2 * D + col;
        float w[64];
#pragma unroll
        for (int k = 0; k < 64; ++k) w[k] = __int_as_float(__builtin_amdgcn_readfirstlane(__float_as_int(w3[(size_t)k * 2 * D])));
        const float delta = fabsf(mind + (maxd - mind) * (float)c / (float)(D - 1));
        const float* h2 = (const float*)(ws + WS_H2) + (size_t)l * SEQ * 64;
        float* tmp = (float*)(ws + WS_S1) + (size_t)it * SEQ;
        float ss = 0.f;
        f32x4 pre[8];
#pragma unroll
        for (int i = 0; i < 8; ++i) { const int idx = F.tid + NTHR * i; pre[i] = *(const f32x4*)(h2 + (size_t)(idx >> 4) * 64 + 4 * (idx & 15)); }
#pragma unroll 1
        for (int ch = 0; ch < 16; ++ch) {
            __syncthreads();
#pragma unroll
            for (int i = 0; i < 8; ++i) { const int idx = F.tid + NTHR * i; *(LAS f32x4*)(tile + (idx >> 4) * 68 + 4 * (idx & 15)) = pre[i]; }
            __syncthreads();
            { const int nch = (ch < 15) ? ch + 1 : ch;
#pragma unroll
              for (int i = 0; i < 8; ++i) { const int idx = F.tid + NTHR * i; pre[i] = *(const f32x4*)(h2 + (size_t)(256 * nch + (idx >> 4)) * 64 + 4 * (idx & 15)); } }
#pragma unroll
            for (int jj = 0; jj < 4; ++jj) { const int row = F.lane + 64 * jj, t = 256 * ch + row; float dot = 0.f;
#pragma unroll
                for (int k4 = 0; k4 < 16; ++k4) { const f32x4 h = *(const LAS f32x4*)(tile + row * 68 + 4 * k4); dot += h.x * w[4 * k4] + h.y * w[4 * k4 + 1] + h.z * w[4 * k4 + 2] + h.w * w[4 * k4 + 3]; }
                const float val = dot * expf(-((float)t / (float)(SEQ - 1)) * delta); tmp[t] = val; ss += val * val; asm volatile("" ::: "memory"); }
        }
        ss = wave_sum(ss);
        const float scale = 1.0f / sqrtf(ss + 1e-6f);
        bf16* rv = (bf16*)(ws + WS_KFR) + ((size_t)l * D + c) * 8192;
        const float hb = F.in[I_HBIAS][l * D + c];
        asm volatile("s_waitcnt vmcnt(0)" ::: "memory");
#pragma unroll 4
        for (int i = 0; i < 64; ++i) { const int t = F.lane + 64 * i; float val = __uint_as_float(__hip_atomic_load((unsigned*)tmp + t, __ATOMIC_RELAXED, __HIP_MEMORY_SCOPE_AGENT)) * scale;
            if (dir == 0) { if (t == 0) val += hb; rv[4095 - t] = (bf16)f2bf(val); }
            else { if (t > 0) rv[4095 + t] = (bf16)f2bf(val); else rv[8191] = 0; } }
    }
}

__device__ __forceinline__ u32x4 ldrow(const bf16* p, bool ok) { u32x4 q = (u32x4){0u, 0u, 0u, 0u}; if (ok) q = *(const u32x4*)p; return q; }
__device__ __forceinline__ void ld8f(const float* p, float (&f)[8]) { const f32x4 a = *(const f32x4*)p, b = *(const f32x4*)(p + 4); f[0] = a.x; f[1] = a.y; f[2] = a.z; f[3] = a.w; f[4] = b.x; f[5] = b.y; f[6] = b.z; f[7] = b.w; }
__device__ __forceinline__ void ph_fix(Frame& F, int l) {
    unsigned char* ws = F.ws;
    const bf16* SB = (const bf16*)(ws + WS_SB); bf16* YA = (bf16*)F.out; bf16* ZT = (bf16*)(ws + WS_S4);
    constexpr size_t SBN = (size_t)(T / 32) * D;
    const float* caw = F.in[I_CAW] + (size_t)l * 3 * D; const float* chw = F.in[I_CHW] + (size_t)l * 3 * 3 * D;
    const int k0 = F.loc ? 128 * (int)(blockIdx.x & 7) + 4 * (int)(blockIdx.x >> 3) + F.wave : F.gw, kend = F.loc ? (F.wave < 4 ? k0 + 1 : k0) : T / 64;
    for (int k = k0; k < kend; k += F.NGW) {
        const int t = 64 * k + 63;
        if (((t + 1) & (SEQ - 1)) == 0) continue;
        const int b = t >> 12, p = t & (SEQ - 1);
#pragma unroll 1
        for (int h = 0; h < 2; ++h) {
            const int c0 = 8 * (F.lane + 64 * h); const size_t s0 = (size_t)(2 * k + 1) * D + c0, s1 = (size_t)(2 * k + 2) * D + c0;
            { float ab0[8], ab1[8], cu0[8], cu1[8], w0[8], w2[8], y0[8], y1[8];
              unpack8(*(const u32x4*)(SB + s0), ab0); unpack8(*(const u32x4*)(SB + s1), ab1); unpack8(*(const u32x4*)(SB + SBN + s0), cu0); unpack8(*(const u32x4*)(SB + SBN + s1), cu1);
              ld8f(caw + c0, w0); ld8f(caw + 2 * D + c0, w2);
              unpack8(*(const u32x4*)(YA + (size_t)t * D + c0), y0); unpack8(*(const u32x4*)(YA + (size_t)(t + 1) * D + c0), y1);
#pragma unroll
              for (int j = 0; j < 8; ++j) { y0[j] += ab0[j] * w2[j] * cu1[j]; y1[j] += ab1[j] * w0[j] * cu0[j]; }
              *(u32x4*)(YA + (size_t)t * D + c0) = pack8f(y0); *(u32x4*)(YA + (size_t)(t + 1) * D + c0) = pack8f(y1); }
            { float pv0[8], pv1[8], px0[8], px1[8], v0[8], v1[8], x0[8], x1[8], wv0[8], wv2[8], wx0[8], wx2[8];
              unpack8(*(const u32x4*)(SB + 2 * SBN + s0), pv0); unpack8(*(const u32x4*)(SB + 2 * SBN + s1), pv1); unpack8(*(const u32x4*)(SB + 3 * SBN + s0), px0); unpack8(*(const u32x4*)(SB + 3 * SBN + s1), px1);
              unpack8(*(const u32x4*)(SB + 4 * SBN + s0), v0); unpack8(*(const u32x4*)(SB + 4 * SBN + s1), v1); unpack8(*(const u32x4*)(SB + 5 * SBN + s0), x0); unpack8(*(const u32x4*)(SB + 5 * SBN + s1), x1);
              ld8f(chw + c0, wv0); ld8f(chw + 6 * D + c0, wv2); ld8f(chw + D + c0, wx0); ld8f(chw + 7 * D + c0, wx2);
#pragma unroll
              for (int j = 0; j < 8; ++j) { const float z0 = (pv0[j] + wv2[j] * v1[j]) * (px0[j] + wx2[j] * x1[j]), z1 = (pv1[j] + wv0[j] * v0[j]) * (px1[j] + wx0[j] * x0[j]);
                  bf16* zp = ZT + ((size_t)(c0 + j) * NB + b) * SEQ + p; const unsigned zz = cvt_pk_bf16(z0, z1);
                  zp[0] = (bf16)(zz & 0xffffu); zp[1] = (bf16)(zz >> 16); } }
        }
    }
}

constexpr int CONV_CS = 16448;
__device__ __forceinline__ bf16x8 conv_ldfrag(const LAS unsigned char* p) { const u32x2 lo = *(const LAS u32x2*)p, hi = *(const LAS u32x2*)(p + 8); return __builtin_bit_cast(bf16x8, (u32x4){lo.x, lo.y, hi.x, hi.y}); }
__device__ __forceinline__ void ph_conv(Frame& F, int l) {
    unsigned char* ws = F.ws;
    const bf16* ZT = (const bf16*)(ws + WS_S4); const bf16* X0T = (const bf16*)(ws + WS_S3);
    const float* chw = F.in[I_CHW] + (size_t)l * 3 * 3 * D; const float* chb = F.in[I_CHB] + (size_t)l * 3 * D;
    const int lane = F.lane, r = lane & 15, g = lane >> 4, mcopy = (3 - r) & 3;
    typedef unsigned u32x4u __attribute__((ext_vector_type(4), aligned(4)));
    bf16x8 B0[8], B1[8];
#define CONV_LDB(dst, p) do { \
    asm volatile("global_load_dwordx4 %0, %1, off" : "=&v"(dst[0]) : "v"(p)); asm volatile("global_load_dwordx4 %0, %1, off offset:64" : "=&v"(dst[1]) : "v"(p)); \
    asm volatile("global_load_dwordx4 %0, %1, off offset:128" : "=&v"(dst[2]) : "v"(p)); asm volatile("global_load_dwordx4 %0, %1, off offset:192" : "=&v"(dst[3]) : "v"(p)); \
    asm volatile("global_load_dwordx4 %0, %1, off offset:256" : "=&v"(dst[4]) : "v"(p)); asm volatile("global_load_dwordx4 %0, %1, off offset:320" : "=&v"(dst[5]) : "v"(p)); \
    asm volatile("global_load_dwordx4 %0, %1, off offset:384" : "=&v"(dst[6]) : "v"(p)); asm volatile("global_load_dwordx4 %0, %1, off offset:448" : "=&v"(dst[7]) : "v"(p)); } while (0)
#define CONV_WAITB(dst) asm volatile("s_waitcnt vmcnt(0)" : "+v"(dst[0]), "+v"(dst[1]), "+v"(dst[2]), "+v"(dst[3]), "+v"(dst[4]), "+v"(dst[5]), "+v"(dst[6]), "+v"(dst[7]))
#define CONV_BLOCK(Bc, blk) do { const LAS unsigned char* fb = fbase + 512 * (blk); \
    _Pragma("unroll") for (int q = 0; q < 8; ++q) { \
        _Pragma("unroll") for (int ti = 15; ti >= 14; --ti) acc[ti] = __builtin_amdgcn_mfma_f32_16x16x32_bf16(Fw[(2 * q - ti) & 15], Bc[q], acc[ti], 0, 0, 0); \
        Fw[(2 * q + 1) & 15] = conv_ldfrag(fb + 32 * (2 * q + 1)); Fw[(2 * q + 2) & 15] = conv_ldfrag(fb + 32 * (2 * q + 2));     \
        _Pragma("unroll") for (int ti = 13; ti >= 0; --ti) acc[ti] = __builtin_amdgcn_mfma_f32_16x16x32_bf16(Fw[(2 * q - ti) & 15], Bc[q], acc[ti], 0, 0, 0); \
        __builtin_amdgcn_sched_group_barrier(0x008, 2, 0); __builtin_amdgcn_sched_group_barrier(0x100, 2, 0); __builtin_amdgcn_sched_group_barrier(0x008, 14, 0); } } while (0)
    { const bf16* zp = ZT + ((size_t)blockIdx.x * NB + r) * SEQ + 8 * g; CONV_LDB(B0, zp); }
    for (int c = blockIdx.x; c < D; c += F.G) {
        const bf16* rv = (const bf16*)(ws + WS_KFR) + ((size_t)l * D + c) * 8192;
        for (int q = F.tid; q < 1024; q += NTHR) {
            const u32x4 a = *(const u32x4*)(rv + 8 * q); u32x2 b = (u32x2){0u, 0u}; if (q < 1023) b = *(const u32x2*)(rv + 8 * q + 8);
            const unsigned d0 = a.x, d1 = a.y, d2 = a.z, d3 = a.w, d4 = b.x, d5 = b.y;
            *(LAS u32x4*)(F.lds + 0 * CONV_CS + 16 * q) = (u32x4){d0, d1, d2, d3};
            *(LAS u32x4*)(F.lds + 1 * CONV_CS + 16 * q) = (u32x4){__builtin_amdgcn_alignbit(d1, d0, 16), __builtin_amdgcn_alignbit(d2, d1, 16), __builtin_amdgcn_alignbit(d3, d2, 16), __builtin_amdgcn_alignbit(d4, d3, 16)};
            *(LAS u32x4*)(F.lds + 2 * CONV_CS + 16 * q) = (u32x4){d1, d2, d3, d4};
            *(LAS u32x4*)(F.lds + 3 * CONV_CS + 16 * q) = (u32x4){__builtin_amdgcn_alignbit(d2, d1, 16), __builtin_amdgcn_alignbit(d3, d2, 16), __builtin_amdgcn_alignbit(d4, d3, 16), __builtin_amdgcn_alignbit(d5, d4, 16)};
        }
        __syncthreads();
        const bf16* zrow = ZT + ((size_t)c * NB + r) * SEQ + 8 * g;
#pragma unroll 1
        for (int tbk = 0; tbk < 2; ++tbk) {
            const int tb = 256 * (2 * F.wave + tbk);
            const LAS unsigned char* fbase = F.lds + mcopy * CONV_CS + 2 * (4092 - tb - 4 * (r >> 2) + 8 * g);
            f32x4 acc[16];
#pragma unroll
            for (int i = 0; i < 16; ++i) acc[i] = (f32x4){0.f, 0.f, 0.f, 0.f};
            bf16x8 Fw[16];
#pragma unroll
            for (int u = -15; u <= 0; ++u) Fw[u & 15] = conv_ldfrag(fbase + 32 * u);
            CONV_WAITB(B0);
#pragma unroll 1
            for (int b2 = 0; b2 < 7; ++b2) {
                { const bf16* zp = zrow + 256 * (2 * b2 + 1); CONV_LDB(B1, zp); }
                CONV_BLOCK(B0, 2 * b2);
                CONV_WAITB(B1);
                { const bf16* zp = zrow + 256 * (2 * b2 + 2); CONV_LDB(B0, zp); }
                CONV_BLOCK(B1, 2 * b2 + 1);
                CONV_WAITB(B0);
            }
            { const bf16* zp = zrow + 256 * 15; CONV_LDB(B1, zp); }
            CONV_BLOCK(B0, 14);
            CONV_WAITB(B1);
            { const int cn = (c + F.G < D) ? c + F.G : c;
              const bf16* zp = (tbk == 0) ? zrow : ZT + ((size_t)cn * NB + r) * SEQ + 8 * g; CONV_LDB(B0, zp); }
            CONV_BLOCK(B1, 15);
            const bf16* xrow = X0T + ((size_t)c * NB + r) * SEQ + tb + 4 * g; bf16* orow = (bf16*)F.out + (size_t)T * D + ((size_t)c * NB + r) * SEQ + tb + 4 * g;
            const float xw0 = chw[2 * D + c], xw1 = chw[5 * D + c], xw2 = chw[8 * D + c], xb = chb[2 * D + c];
#pragma unroll
            for (int ti = 0; ti < 16; ++ti) { const int t0 = tb + 16 * ti + 4 * g; const u32x4u x = *(const u32x4u*)(xrow + 16 * ti - 2);
                float e[6]; e[1] = bflo(x.y); e[2] = bfhi(x.y); e[3] = bflo(x.z); e[4] = bfhi(x.z);
                e[0] = (t0 > 0) ? bfhi(x.x) : 0.f; e[5] = (t0 + 4 < SEQ) ? bflo(x.w) : 0.f;
                float y[4];
#pragma unroll
                for (int k = 0; k < 4; ++k) y[k] = (xb + xw0 * e[k] + xw1 * e[k + 1] + xw2 * e[k + 2]) * acc[ti][k];
                u32x2 o; o.x = cvt_pk_bf16(y[0], y[1]); o.y = cvt_pk_bf16(y[2], y[3]);
                *(u32x2*)(orow + 16 * ti) = o; }
        }
        __syncthreads();
    }
    CONV_WAITB(B0);
#undef CONV_LDB
#undef CONV_WAITB
#undef CONV_BLOCK
}

__device__ __forceinline__ void ph_tr(Frame& F) {
    unsigned char* ws = F.ws;
    const bf16* src = (const bf16*)F.out + (size_t)T * D; bf16* dst = (bf16*)(ws + WS_S3);
    LAS unsigned char* scr = F.lds + F.wave * 8192;
    const int lane = F.lane;
    for (int it = F.gw; it < NB * (SEQ / 64) * (D / 64); it += F.NGW) {
        const int ct = it % (D / 64), tt = (it / (D / 64)) % (SEQ / 64), b = it / ((D / 64) * (SEQ / 64));
        const int c0 = ct * 64, t0 = tt * 64;
#pragma unroll
        for (int k = 0; k < 8; ++k) { const int idx = lane + 64 * k, crow = idx >> 3, q = idx & 7;
            const u32x4 v = *(const u32x4*)(src + ((size_t)(c0 + crow) * NB + b) * SEQ + t0 + 8 * q);
            const unsigned w[4] = {v.x, v.y, v.z, v.w};
#pragma unroll
            for (int i = 0; i < 8; ++i) { const unsigned short h = (unsigned short)((i & 1) ? (w[i >> 1] >> 16) : (w[i >> 1] & 0xffffu));
                *(LAS unsigned short*)(scr + (8 * q + i) * 128 + 2 * (crow ^ (q << 3))) = h; } }
        asm volatile("s_waitcnt lgkmcnt(0)" ::: "memory");
#pragma unroll
        for (int k = 0; k < 8; ++k) { const int idx = lane + 64 * k, t = idx >> 3, ch = idx & 7;
            const u32x4 v = *(const LAS u32x4*)(scr + t * 128 + 16 * (ch ^ ((t >> 3) & 7)));
            *(u32x4*)(dst + ((size_t)b * SEQ + t0 + t) * D + c0 + 8 * ch) = v; }
        asm volatile("s_waitcnt lgkmcnt(0)" ::: "memory");
    }
}

template <int MODE> __device__ __forceinline__ void ph_ln(Frame& F, const float* gsrc, const float* bsrc) {
    unsigned char* ws = F.ws;
    const bf16* S = (const bf16*)F.out; bf16* H = (bf16*)(ws + WS_H);
    f32x4 g[4], b[4];
    __syncthreads();
    LAS f32x4* gl = (LAS f32x4*)(F.lds + 4096);
    if (MODE == 1) { if (F.tid < 256) { gl[F.tid] = ((const f32x4*)gsrc)[F.tid]; gl[256 + F.tid] = ((const f32x4*)bsrc)[F.tid]; } }
    else {
#pragma unroll
        for (int j = 0; j < 4; ++j) { g[j] = ((const f32x4*)gsrc)[F.lane + 64 * j]; b[j] = ((const f32x4*)bsrc)[F.lane + 64 * j]; } }
    LAS int* leid = (LAS int*)(F.lds);
    constexpr int R = 4;
    const LAS f32x4* rt = (const LAS f32x4*)(F.lds + 16384);
    if (MODE == 1) { const float* Rg = F.in[I_ROUTER]; LAS float* rtw = (LAS float*)(F.lds + 16384);
        for (int idx = F.tid; idx < D * NE; idx += NTHR) rtw[(idx & 7) * D + (idx >> 3)] = Rg[idx];
        __syncthreads(); }
    for (int it = F.it0; it < T / 256; it += F.G) {
        if (MODE == 1) __syncthreads();
        u32x2 nq[R][4];
#pragma unroll
        for (int r = 0; r < R; ++r) { const u32x2* xr = (const u32x2*)(S + (size_t)(it * 256 + F.wave * 32 + r) * D) + F.lane;
#pragma unroll
            for (int j = 0; j < 4; ++j) if (MODE != 1) nq[r][j] = xr[64 * j]; }
        for (int rr = 0; rr < 32; rr += R) {
            const int tl0 = F.wave * 32 + rr, m0 = it * 256 + tl0;
            f32x4 v[R][4];
#pragma unroll
            for (int r = 0; r < R; ++r)
#pragma unroll
                for (int j = 0; j < 4; ++j) { u32x2 q; if (MODE != 1) q = nq[r][j]; else q = ((const u32x2*)(S + (size_t)(m0 + r) * D) + F.lane)[64 * j]; v[r][j] = (f32x4){bflo(q.x), bfhi(q.x), bflo(q.y), bfhi(q.y)}; }
            if (MODE != 1) { const int nr = (rr + R < 32) ? rr + R : rr;
#pragma unroll
              for (int r = 0; r < R; ++r) { const u32x2* xr = (const u32x2*)(S + (size_t)(it * 256 + F.wave * 32 + nr + r) * D) + F.lane;
#pragma unroll
                  for (int j = 0; j < 4; ++j) nq[r][j] = xr[64 * j]; } }
            ln_rows<R, MODE == 1>(v, g, b, gl, F.lane);
#pragma unroll
            for (int r = 0; r < R; ++r) store_row_bf16(H + (size_t)(m0 + r) * D, F.lane, v[r]);
            if (MODE == 2) {
#pragma unroll
                for (int r = 0; r < R; ++r) { unsigned* h8 = (unsigned*)(ws + WS_H8F + (size_t)(m0 + r) * D) + F.lane;
#pragma unroll
                    for (int j = 0; j < 4; ++j) { unsigned a = 0; a = __builtin_amdgcn_cvt_pk_fp8_f32(v[r][j].x * F8_H, v[r][j].y * F8_H, a, false); a = __builtin_amdgcn_cvt_pk_fp8_f32(v[r][j].z * F8_H, v[r][j].w * F8_H, a, true); h8[64 * j] = a; } } }
            if (MODE == 1) {
                float lg[R][8];
#pragma unroll
                for (int r = 0; r < R; ++r)
#pragma unroll
                    for (int e = 0; e < 8; ++e) lg[r][e] = 0.f;
#pragma unroll
                for (int j = 0; j < 4; ++j) {
#pragma unroll
                    for (int e = 0; e < 8; ++e) { const f32x4 q = rt[e * 256 + F.lane + 64 * j];
#pragma unroll
                        for (int r = 0; r < R; ++r) lg[r][e] += (v[r][j].x * q.x + v[r][j].y * q.y) + (v[r][j].z * q.z + v[r][j].w * q.w); }
                    asm volatile("" ::: "memory"); }
                static_assert(R == 4, "router reduction is written for 4 rows");
                float w[32];
#pragma unroll
                for (int r = 0; r < R; ++r)
#pragma unroll
                    for (int e = 0; e < 8; ++e) w[8 * r + e] = lg[r][e];
#pragma unroll
                for (int st = 0; st < 5; ++st) { const int half = 16 >> st, o = 1 << st; const bool hi = (F.lane & o) != 0;
#pragma unroll
                    for (int i = 0; i < half; ++i) { const float keep = hi ? w[i + half] : w[i], send = hi ? w[i] : w[i + half]; w[i] = keep + __shfl_xor(send, o); } }
                w[0] += __shfl_xor(w[0], 32);
                const bool e0 = (F.lane & 16) != 0, e1 = (F.lane & 8) != 0, e2 = (F.lane & 4) != 0;
                float ga[2], gb[4], g8[8];
                { const float rc = __shfl_xor(w[0], 16); ga[0] = e0 ? rc : w[0]; ga[1] = e0 ? w[0] : rc; }
#pragma unroll
                for (int x = 0; x < 2; ++x) { const float rc = __shfl_xor(ga[x], 8); gb[x] = e1 ? rc : ga[x]; gb[2 + x] = e1 ? ga[x] : rc; }
#pragma unroll
                for (int x = 0; x < 4; ++x) { const float rc = __shfl_xor(gb[x], 4); g8[x] = e2 ? rc : gb[x]; g8[4 + x] = e2 ? gb[x] : rc; }
                { const int r = ((F.lane & 1) << 1) | ((F.lane >> 1) & 1);
                    int i1 = 0; float v1 = g8[0];
#pragma unroll
                    for (int e = 1; e < 8; ++e) if (g8[e] > v1) { v1 = g8[e]; i1 = e; }
                    int i2 = (i1 == 0) ? 1 : 0; float v2 = -3.0e38f;
#pragma unroll
                    for (int e = 0; e < 8; ++e) if (e != i1 && g8[e] > v2) { v2 = g8[e]; i2 = e; }
                    const float w1 = 1.0f / (1.0f + expf(v2 - v1)), w2 = 1.0f - w1;
                    const int m = m0 + r, tl = tl0 + r;
                    if (F.lane < 4) { int* eid = (int*)(ws + WS_EID); float* wg = (float*)(ws + WS_WGT); eid[2 * m] = i1; eid[2 * m + 1] = i2; wg[2 * m] = w1; wg[2 * m + 1] = w2; leid[2 * tl] = i1; leid[2 * tl + 1] = i2; } }
            }
        }
        if (MODE == 1) {
            __syncthreads();
            if (F.wave == 0) {
                int cnt[8];
#pragma unroll
                for (int e = 0; e < 8; ++e) cnt[e] = 0;
                int* lrank = (int*)(ws + WS_POS) + (size_t)it * 512;
                for (int k = 0; k < 8; ++k) { const int j = 64 * k + F.lane; const int e = leid[j]; int rk = 0;
#pragma unroll
                    for (int ee = 0; ee < 8; ++ee) { const unsigned long long mask = __ballot(e == ee); const int below = __popcll(mask & ((1ull << F.lane) - 1ull)); if (e == ee) rk = cnt[ee] + below; cnt[ee] += __popcll(mask); }
                    lrank[j] = rk; }
                if (F.lane < 8) { int cv = 0;
#pragma unroll
                    for (int e = 0; e < 8; ++e) cv = (F.lane == e) ? cnt[e] : cv;
                    ((int*)(ws + WS_BCNT))[it * 8 + F.lane] = cv; }
            }
        }
    }
}

__device__ __forceinline__ void ph_gather(Frame& F) {
    unsigned char* ws = F.ws;
    const int* bcnt = (const int*)(ws + WS_BCNT); const int* eid = (const int*)(ws + WS_EID); const int* pos = (const int*)(ws + WS_POS); int* pos2 = (int*)(ws + WS_POS2);
    const bf16* H = (const bf16*)(ws + WS_H); unsigned char* HP8 = ws + WS_HP8;
    LAS int* tab = (LAS int*)(F.lds);
    constexpr int BPC = CHT / 256;
    __syncthreads();
    for (int it = blockIdx.x; it < T / 256; it += F.G) {
        const int ck = it / BPC, ib = it % BPC;
        __syncthreads();
        if (F.tid < 8) { int tot = 0, before = 0; for (int j = 0; j < BPC; ++j) { const int v = bcnt[(ck * BPC + j) * 8 + F.tid]; tot += v; if (j < ib) before += v; } tab[16 + F.tid] = tot; tab[8 + F.tid] = before; }
        __syncthreads();
        if (F.tid == 0) { int s = 0; for (int e = 0; e < 8; ++e) { tab[e] = s; s += (tab[16 + e] + 255) & ~255; }
            if (ib == 0) { int* gt = (int*)(ws + WS_TAB) + ck * 16; int ts = 0; for (int e = 0; e < 8; ++e) { gt[e] = ts; ts += (tab[16 + e] + 255) >> 8; } gt[8] = ts; } }
        __syncthreads();
        { const int j = F.tid; const int e = eid[(size_t)it * 512 + j]; const int p = ck * CH_ROWS + tab[e] + tab[8 + e] + pos[(size_t)it * 512 + j]; pos2[(size_t)it * 512 + j] = p;
          ((LAS int*)(F.lds + 1024))[j] = p; }
        __syncthreads();
        for (int k0 = 0; k0 < 64; k0 += 8) { u32x4 va[8], vb[8]; int pp[8];
#pragma unroll
            for (int k = 0; k < 8; ++k) { const int j = F.wave * 64 + k0 + k; pp[k] = ((LAS int*)(F.lds + 1024))[j]; const int m = it * 256 + (j >> 1);
                const u32x4* s = (const u32x4*)(H + (size_t)m * D); va[k] = s[F.lane]; vb[k] = s[F.lane + 64]; }
#pragma unroll
            for (int k = 0; k < 8; ++k) { u32x2* d = (u32x2*)(HP8 + (size_t)pp[k] * D); float f[8]; unsigned a, b;
                unpack8(va[k], f); a = 0; b = 0; a = __builtin_amdgcn_cvt_pk_fp8_f32(f[0] * F8_H, f[1] * F8_H, a, false); a = __builtin_amdgcn_cvt_pk_fp8_f32(f[2] * F8_H, f[3] * F8_H, a, true); b = __builtin_amdgcn_cvt_pk_fp8_f32(f[4] * F8_H, f[5] * F8_H, b, false); b = __builtin_amdgcn_cvt_pk_fp8_f32(f[6] * F8_H, f[7] * F8_H, b, true); d[F.lane] = (u32x2){a, b};
                unpack8(vb[k], f); a = 0; b = 0; a = __builtin_amdgcn_cvt_pk_fp8_f32(f[0] * F8_H, f[1] * F8_H, a, false); a = __builtin_amdgcn_cvt_pk_fp8_f32(f[2] * F8_H, f[3] * F8_H, a, true); b = __builtin_amdgcn_cvt_pk_fp8_f32(f[4] * F8_H, f[5] * F8_H, b, false); b = __builtin_amdgcn_cvt_pk_fp8_f32(f[6] * F8_H, f[7] * F8_H, b, true); d[F.lane + 64] = (u32x2){a, b}; } }
        if (ib < 8) { const int e = ib, n = tab[16 + e], r0 = ck * CH_ROWS + tab[e] + n, npad = ((n + 255) & ~255) - n;
            unsigned zz = 0u; asm volatile("" : "+v"(zz));
            for (int k = F.wave; k < npad; k += NWAVES) { u32x4* d = (u32x4*)(HP8 + (size_t)(r0 + k) * D); d[F.lane] = (u32x4){zz, zz, zz, zz}; } }
    }
}
__device__ __forceinline__ void ph_moeconv(Frame& F) {
    unsigned char* ws = F.ws; (void)ws;
    {
        __syncthreads();
        LAS float* scr = (LAS float*)(F.lds + F.wave * 16384);
        constexpr int I_13 = (D / 64) * (DFE / 32), I_2 = (DFE / 64) * (D / 32);
        constexpr int NIT = NE * (2 * I_13 + I_2);
        auto dec = [&](int it) -> TrItem { const int e = it / (2 * I_13 + I_2); const int r = it % (2 * I_13 + I_2); TrItem t;
            if (r < 2 * I_13) { const int sel = r / I_13; t = TrItem{F.in[sel == 0 ? I_M1 : I_M3] + (size_t)e * D * DFE, (bf16*)((unsigned char*)F.out + OUT_MW13 + (size_t)e * 2 * DFE * D), D, DFE, sel, r % I_13, F8_W13 * (sel == 0 ? SWG_W1 : SWG_W3)}; }
            else t = TrItem{F.in[I_M2] + (size_t)e * DFE * D, (bf16*)((unsigned char*)F.out + OUT_MW2 + (size_t)e * D * DFE), DFE, D, -1, r - 2 * I_13, F8_W2};
            return t; };
        TR_LOOP(NIT, dec)
    }
}

__device__ __forceinline__ void ph_final(Frame& F, const float* gsrc, const float* bsrc, int r_lo, int r_hi, int first_blk) {
    unsigned char* ws = F.ws;
    const bf16* H = (const bf16*)(ws + WS_H); const bf16* Y = (const bf16*)(ws + WS_Y); unsigned* pos = (unsigned*)(ws + WS_POS2); unsigned* wg = (unsigned*)(ws + WS_WGT);
    f32x4 g[4], b[4];
#pragma unroll
    for (int j = 0; j < 4; ++j) { g[j] = ((const f32x4*)gsrc)[F.lane + 64 * j]; b[j] = ((const f32x4*)bsrc)[F.lane + 64 * j]; }
    if ((int)blockIdx.x < first_blk) return;
    const int gw2 = ((int)blockIdx.x - first_blk) * NWAVES + F.wave, ngw2 = (F.G - first_blk) * NWAVES;
    for (int m0 = r_lo + gw2 * 4; m0 < r_hi; m0 += ngw2 * 4) {
        int p0[4], p1[4]; float w0[4], w1[4];
#pragma unroll
        for (int r = 0; r < 4; ++r) { const int m = m0 + r;
            p0[r] = (int)__hip_atomic_load(pos + 2 * m, __ATOMIC_RELAXED, __HIP_MEMORY_SCOPE_AGENT); p1[r] = (int)__hip_atomic_load(pos + 2 * m + 1, __ATOMIC_RELAXED, __HIP_MEMORY_SCOPE_AGENT);
            w0[r] = __uint_as_float(__hip_atomic_load(wg + 2 * m, __ATOMIC_RELAXED, __HIP_MEMORY_SCOPE_AGENT)); w1[r] = __uint_as_float(__hip_atomic_load(wg + 2 * m + 1, __ATOMIC_RELAXED, __HIP_MEMORY_SCOPE_AGENT)); }
        f32x4 v[4][4];
#pragma unroll
        for (int r = 0; r < 4; ++r) { const int m = m0 + r;
            const u32x2* hr = (const u32x2*)(H + (size_t)m * D) + F.lane; const u32x2* y0 = (const u32x2*)(Y + (size_t)p0[r] * D) + F.lane; const u32x2* y1 = (const u32x2*)(Y + (size_t)p1[r] * D) + F.lane;
#pragma unroll
            for (int j = 0; j < 4; ++j) { const u32x2 h = hr[64 * j], a = y0[64 * j], c = y1[64 * j];
                v[r][j].x = ALPHA * bflo(h.x) + w0[r] * bflo(a.x) + w1[r] * bflo(c.x); v[r][j].y = ALPHA * bfhi(h.x) + w0[r] * bfhi(a.x) + w1[r] * bfhi(c.x);
                v[r][j].z = ALPHA * bflo(h.y) + w0[r] * bflo(a.y) + w1[r] * bflo(c.y); v[r][j].w = ALPHA * bfhi(h.y) + w0[r] * bfhi(a.y) + w1[r] * bfhi(c.y); } }
        ln_rows<4>(v, g, b);
#pragma unroll
        for (int r = 0; r < 4; ++r) { f32x4* o = (f32x4*)(F.out + (size_t)(m0 + r) * D) + F.lane;
#pragma unroll
            for (int j = 0; j < 4; ++j) __builtin_nontemporal_store(v[r][j], &o[64 * j]); }
    }
}

constexpr int MOE_SKIP = 3;
constexpr int NPHASES = 2 + NLAYER * 6 + 3 + 2 + (NCH + 1);
__device__ __forceinline__ Frame mk_frame(const Args& args, LAS unsigned char* lds) {
    Frame F; int tid = threadIdx.x; asm volatile("" : "+v"(tid));
    size_t zo = 0; asm volatile("" : "+s"(zo));
    unsigned char* ws = args.ws + zo; float* out = (float*)((unsigned char*)args.out + zo);
    F.lds = lds; F.tid = tid; F.lane = tid & 63; F.wave = __builtin_amdgcn_readfirstlane(tid >> 6);
    F.G = gridDim.x; F.gw = blockIdx.x * NWAVES + F.wave; F.NGW = F.G * NWAVES; F.in = args.in; F.out = out; F.ws = ws;
    F.loc = (gridDim.x == 256) && !MK_PER_PHASE; F.it0 = F.loc ? 32 * (int)(blockIdx.x & 7) + (int)(blockIdx.x >> 3) : (int)blockIdx.x; return F;
}
__global__ void __launch_bounds__(NTHR, 2) mega_fwd(Args args) {
    extern __shared__ __attribute__((aligned(16))) unsigned char lds[];
    volatile LAS unsigned* MISC = (volatile LAS unsigned*)((LAS unsigned char*)lds + MISC_OFF);
    if (threadIdx.x < 32) MISC[threadIdx.x] = 0u;
    __syncthreads();
    XcdBarrier bar; bar.bar = (unsigned*)(args.ws + WS_CTL) + CW_BAR; bar.x = 0; bar.st = nullptr;
    if (!MK_PER_PHASE) bar = xcd_barrier_post((unsigned*)(args.ws + WS_CTL) + CW_BAR, MISC + 8);
    const int lo = args.ph_lo, hi = args.ph_hi;
    int pc = 0; unsigned ggen = 0u;
#define PH_BEGIN if (pc >= lo && pc < hi) { Frame F = mk_frame(args, (LAS unsigned char*)lds); unsigned char* ws = F.ws; PG8_LAS unsigned char* glds = (PG8_LAS unsigned char*)F.lds; bf16* H = (bf16*)(ws + WS_H); (void)glds; (void)H;
#define PH_END   if (pc + 1 < hi) xcd_barrier(bar); } ++pc;
#define PH_END_L if (pc + 1 < hi) { if (F.loc) grp_barrier(bar.bar, blockIdx.x & 7u, gridDim.x >> 3, ggen); else xcd_barrier(bar); } } ++pc;

    PH_BEGIN ph_prologue_a(F); PH_END
    PH_BEGIN ph_prologue_b(F); PH_END
    for (int l = 0; l < NLAYER; ++l) {
        PH_BEGIN { { pg8::Gemm g{H, (const bf16*)(ws + WS_WINT) + (size_t)l * PROJ * D, T, 24 * 256, D}; pg8::StaticOrder S; S.init(T, 24 * 256, F.G, (int)blockIdx.x);
                     pg8::EpiProj E{(bf16*)F.out, (bf16*)(ws + WS_S3), (bf16*)(ws + WS_S4), (bf16*)(ws + WS_S5), (bf16*)(ws + WS_S6), (bf16*)(ws + WS_SB),
                                    F.in[I_CAW] + (size_t)l * 3 * D, F.in[I_CHW] + (size_t)l * 3 * 3 * D, F.in[I_CHB] + (size_t)l * 3 * D};
                     pg8::gemm_phase<pg8::EpiProj, pg8::StaticOrder, false, true>(glds, g, S, E); }
                   __syncthreads();
                   { pg8::Gemm g{(const bf16*)(ws + WS_H8F), (const bf16*)(ws + WS_WINT + (size_t)l * PROJ * D * 2 + WING_OFF), T, 8 * 256, D, E8_H, E8_W13}; pg8::StaticOrder S; S.init(T, 8 * 256, F.G, (int)blockIdx.x);
                     pg8::EpiGate8 E{(bf16*)(ws + WS_S5), (bf16*)(ws + WS_S6)}; pg8::gemm_phase<pg8::EpiGate8, pg8::StaticOrder, true, true, true>(glds, g, S, E); }
                   } PH_END_L
        PH_BEGIN ph_fix(F, l); PH_END
        PH_BEGIN ph_conv(F, l); PH_END
        PH_BEGIN { pg8::Gemm g{(const bf16*)F.out, (const bf16*)(ws + WS_WAT) + (size_t)l * D * D, T, D, 2 * D, 0, 0, (const bf16*)F.out + (size_t)T * D, (const bf16*)(ws + WS_WHT) + (size_t)l * D * D}; pg8::StaticOrder S; S.init(T, D, F.G, (int)blockIdx.x);
                   pg8::EpiMerge2 E{(const bf16*)(ws + WS_S5), (const bf16*)(ws + WS_S6), (bf16*)(ws + WS_S5), D}; pg8::gemm_phase<pg8::EpiMerge2, pg8::StaticOrder, true, true, false, true, true>(glds, g, S, E); } PH_END_L
        PH_BEGIN { pg8::Gemm g{(const bf16*)(ws + WS_S5), (const bf16*)(ws + WS_WOT) + (size_t)l * D * D, T, D, D}; pg8::StaticOrder S; S.init(T, D, F.G, (int)blockIdx.x, 1);
                   pg8::EpiResBf16 E{(bf16*)F.out, H, D, ALPHA}; pg8::gemm_phase<pg8::EpiResBf16, pg8::StaticOrder, true, true>(glds, g, S, E); } PH_END_L
        if (l == 0) {
            PH_BEGIN ph_ln<2>(F, F.in[I_LNMG], F.in[I_LNMB]); PH_END_L
            PH_BEGIN { pg8::Gemm g{(const bf16*)(ws + WS_H8F), (const bf16*)(ws + WS_W13), T, 2 * DFF, D, E8_H, E8_W13}; pg8::StaticOrder S; S.init(T, 2 * DFF, F.G, (int)blockIdx.x);
                       pg8::EpiSwiglu8 E{ws + WS_ACT0, DFF, 0, F8_ACT}; pg8::gemm_phase<pg8::EpiSwiglu8, pg8::StaticOrder, true, true, true>(glds, g, S, E); } PH_END_L
            PH_BEGIN { pg8::Gemm g{(const bf16*)(ws + WS_ACT0), (const bf16*)(ws + WS_W2), T, D, DFF, E8_ACT, E8_W2}; pg8::StaticOrder S; S.init(T, D, F.G, (int)blockIdx.x, 1);
                       pg8::EpiResBf16 E{(bf16*)F.out, H, D, ALPHA}; pg8::gemm_phase<pg8::EpiResBf16, pg8::StaticOrder, true, true, true>(glds, g, S, E); } PH_END_L
            PH_BEGIN ph_ln<2>(F, F.in[I_LNFG], F.in[I_LNFB]); PH_END_L
        } else {
            PH_BEGIN ph_ln<1>(F, F.in[I_LNMG] + D, F.in[I_LNMB] + D); PH_END
            PH_BEGIN { ph_gather(F); ph_moeconv(F); } PH_END
            for (int ck = 0; ck <= NCH; ++ck) {
                PH_BEGIN {
                    int nheavy = 0;
                    if (ck > 0) { const int cd = ck - 1;
                        pg8::Gemm g{(const bf16*)(ws + WS_ACT8 + (size_t)(cd & 1) * ACT8_BYTES), (const bf16*)((unsigned char*)F.out + OUT_MW2), 0, 0, DFE, E8_ACT, E8_W2}; pg8::MoeOrder S; S.initm((const int*)(ws + WS_TAB) + cd * 16, D / 256, F.G, (int)blockIdx.x, 0, 0, 1);
                        nheavy = S.nwg % F.G;
                        pg8::EpiPlain E{(bf16*)(ws + WS_Y) + (size_t)cd * CH_ROWS * D, D, D / 256}; pg8::gemm_phase<pg8::EpiPlain, pg8::MoeOrder, true, true, true>(glds, g, S, E); }
                    __syncthreads();
                    if (ck < NCH) {
                        pg8::Gemm g{(const bf16*)(ws + WS_HP8 + (size_t)ck * CH_ROWS * D), (const bf16*)((unsigned char*)F.out + OUT_MW13), 0, 0, D, E8_H, E8_W13}; pg8::MoeOrder S; S.initm((const int*)(ws + WS_TAB) + ck * 16, 2 * DFE / 256, F.G, (int)blockIdx.x, nheavy, nheavy ? MOE_SKIP : 0);
                        pg8::EpiSwiglu8 E{ws + WS_ACT8 + (size_t)(ck & 1) * ACT8_BYTES, DFE, 2 * DFE / 256, F8_ACT}; pg8::gemm_phase<pg8::EpiSwiglu8, pg8::MoeOrder, true, true, true>(glds, g, S, E); }
                    if (ck == NCH) ph_final(F, F.in[I_LNFG] + D, F.in[I_LNFB] + D, 0, (NCH - 1) * CHT, nheavy);
                } PH_END
            }
            PH_BEGIN ph_final(F, F.in[I_LNFG] + D, F.in[I_LNFB] + D, (NCH - 1) * CHT, T, 0); PH_END
        }
    }
#undef PH_BEGIN
#undef PH_END
#undef PH_END_L
}

extern "C" void kernel_launch(void* const* d_in, const int* in_sizes, int n_in, void* d_out, int out_size, void* d_ws, size_t ws_size, hipStream_t stream) {
    static int grid = 0;
    if (grid == 0) {
        if (n_in != 28 || out_size != T * D || ws_size < WS_END) { fprintf(stderr, "kernel_launch: unexpected shapes (n_in %d, out %d, ws %zu)\n", n_in, out_size, ws_size); grid = -1; return; }
        int dev = 0, cus = 0, per_cu = 0;
        if (hipGetDevice(&dev) != hipSuccess || hipDeviceGetAttribute(&cus, hipDeviceAttributeMultiprocessorCount, dev) != hipSuccess) { grid = -1; return; }
        if (hipFuncSetAttribute((const void*)mega_fwd, hipFuncAttributeMaxDynamicSharedMemorySize, LDS_BYTES) != hipSuccess) { fprintf(stderr, "kernel_launch: hipFuncSetAttribute failed\n"); grid = -1; return; }
        if (hipOccupancyMaxActiveBlocksPerMultiprocessor(&per_cu, (const void*)mega_fwd, NTHR, LDS_BYTES) != hipSuccess || per_cu < 1) fprintf(stderr, "kernel_launch: occupancy query reports %d\n", per_cu);
        (void)hipGetLastError();
        grid = cus;
    }
    if (grid < 0) return;
    (void)hipMemsetAsync((char*)d_ws + WS_CTL, 0, CTL_ZERO_BYTES, stream);
    Args a{};
    for (int i = 0; i < 28; ++i) a.in[i] = (const float*)d_in[i];
    a.out = (float*)d_out; a.ws = (unsigned char*)d_ws;
#if MK_PER_PHASE
    for (int p = 0; p < NPHASES; ++p) { a.ph_lo = p; a.ph_hi = p + 1; hipLaunchKernelGGL(mega_fwd, dim3(grid), dim3(NTHR), LDS_BYTES, stream, a); }
#else
    a.ph_lo = 0; a.ph_hi = NPHASES;
    hipLaunchKernelGGL(mega_fwd, dim3(grid), dim3(NTHR), LDS_BYTES, stream, a);
#endif
}
```
